# Optimizing an MI355X kernel written in HIP

```python
import math
import jax, jax.numpy as jnp
from jax import lax
import numpy as np

D_MODEL = 1024
BATCH = 8
SEQ = 2048
DEPTH = 1
DEC_BATCH = 128
DEC_SEQ = 4
PAST_LEN = 2048
PAGE_SIZE = 128

N_HEADS = 8
N_KV_HEADS = 2
HEAD_DIM = 64
GROUP = N_HEADS // N_KV_HEADS
ATTN_WIDTH = N_HEADS * HEAD_DIM
KV_WIDTH = 2 * N_KV_HEADS * HEAD_DIM
CMP_BLOCK = 32
CMP_STRIDE = 16
CMP_HIDDEN = 128
SEL_BLOCK = 64
TOP_N = 8
WINDOW = 512
Q_BLOCK = 128
NUM_BUCKETS = 32
MAX_EXACT = 16
MAX_DISTANCE = 128
SSM_WIDTH = 512
SSM_GROUP_CH = 16
N_SSM_GROUPS = SSM_WIDTH // SSM_GROUP_CH
SSM_STATE = 64
DT_MIN = 0.001
DT_MAX = 0.1
D_FF = 2816
PLE_DIM = 256
RMS_EPS = 1e-6
NEG_INF = -1e30
BIG = 1e9
SPLIT_POINTS = (ATTN_WIDTH, ATTN_WIDTH + KV_WIDTH, ATTN_WIDTH + 2 * KV_WIDTH, ATTN_WIDTH + 3 * KV_WIDTH,
                ATTN_WIDTH + 3 * KV_WIDTH + 3 * N_HEADS, ATTN_WIDTH + 3 * KV_WIDTH + 3 * N_HEADS + SSM_WIDTH)
IN_WIDTH = SPLIT_POINTS[-1] + 2 * D_MODEL

kernel_name = 'nsa_s5_macaron_hybrid_step'


def rmsnorm(x, g):
    xf = x.astype(jnp.float32)
    var = jnp.mean(xf * xf, axis=-1, keepdims=True)
    return (xf * lax.rsqrt(var + RMS_EPS) * g.astype(jnp.float32)).astype(x.dtype)


def half_ffn(x, g, w_gate, w_up, w_down):
    h = rmsnorm(x, g)
    return x + 0.5 * ((jax.nn.silu(h @ w_gate) * (h @ w_up)) @ w_down)


def ple_add(x, p, g, w_gate, w_proj):
    return x + jax.nn.sigmoid(rmsnorm(x, g) @ w_gate) * (p @ w_proj)


def t5_bucket(dist):
    n = jnp.maximum(dist, 0)
    nf = jnp.maximum(n, 1).astype(jnp.float32)
    large = MAX_EXACT + (jnp.log(nf / MAX_EXACT) / math.log(MAX_DISTANCE / MAX_EXACT)
                         * (NUM_BUCKETS - MAX_EXACT)).astype(jnp.int32)
    large = jnp.minimum(large, NUM_BUCKETS - 1)
    return jnp.where(n < MAX_EXACT, n, large)


def masked_softmax(logits, mask):
    logits = jnp.where(mask, logits.astype(jnp.float32), NEG_INF)
    return jax.nn.softmax(logits, axis=-1) * mask


def compress_rows(rows, pos, w1, b1, w2):
    bn, length = rows.shape[:2]
    n_cmp = (length - CMP_BLOCK) // CMP_STRIDE + 1
    idx = jnp.arange(n_cmp)[:, None] * CMP_STRIDE + jnp.arange(CMP_BLOCK)[None, :]
    blk = rows[:, idx] + pos[None, None, :, None, :]
    blk = jnp.swapaxes(blk, 2, 3).reshape(bn, n_cmp, N_KV_HEADS, CMP_BLOCK * HEAD_DIM)
    return jax.nn.gelu(blk @ w1 + b1) @ w2


def nsa_context(kv_cmp_rows, kv_sel_rows, cmp_params):
    pos_k, w1_k, b1_k, w2_k, pos_v, w1_v, b1_v, w2_v = cmp_params
    bn, length = kv_cmp_rows.shape[:2]
    k_cmp = compress_rows(kv_cmp_rows[:, :, 0], pos_k, w1_k, b1_k, w2_k)
    v_cmp = compress_rows(kv_cmp_rows[:, :, 1], pos_v, w1_v, b1_v, w2_v)
    cmp_end = jnp.arange(k_cmp.shape[1]) * CMP_STRIDE + (CMP_BLOCK - 1)
    n_sel = -(-length // SEL_BLOCK)
    pad = n_sel * SEL_BLOCK - length
    sel = jnp.pad(kv_sel_rows, ((0, 0), (0, pad), (0, 0), (0, 0), (0, 0)))
    sel = sel.reshape(bn, n_sel, SEL_BLOCK, 2, N_KV_HEADS, HEAD_DIM)
    ks_blk = jnp.transpose(sel[:, :, :, 0], (0, 3, 1, 2, 4))
    vs_blk = jnp.transpose(sel[:, :, :, 1], (0, 3, 1, 2, 4))
    return k_cmp, v_cmp, cmp_end, ks_blk, vs_blk


def nsa_queries(q, gates, q_pos, ctx, kv_win, win_pos, rel_bias):
    k_cmp, v_cmp, cmp_end, ks_blk, vs_blk = ctx
    f32 = jnp.float32
    bn, tq = q.shape[:2]
    q = q * HEAD_DIM ** -0.5
    bias_tab = rel_bias.astype(f32).reshape(NUM_BUCKETS, N_KV_HEADS, GROUP)
    h_idx = jnp.arange(N_KV_HEADS)[None, None, :, None]
    dist_c = q_pos[:, None] - cmp_end[None, :]
    bias_c = jnp.transpose(bias_tab[t5_bucket(dist_c)], (0, 2, 3, 1))
    logit_c = jnp.einsum('bqhgd,bchd->bqhgc', q, k_cmp).astype(f32) + bias_c
    p_c = masked_softmax(logit_c, (dist_c >= 0)[:, None, None, :])
    o_c = jnp.einsum('bqhgc,bchd->bqhgd', p_c.astype(v_cmp.dtype), v_cmp)
    n_sel = ks_blk.shape[2]
    sel_start = jnp.arange(n_sel) * SEL_BLOCK
    cmp_start = cmp_end - (CMP_BLOCK - 1)
    cover = ((cmp_start[:, None] < sel_start[None, :] + SEL_BLOCK)
             & (cmp_end[:, None] >= sel_start[None, :])).astype(f32)
    importance = jnp.einsum('bqhgc,cs->bqhs', p_c, cover)
    blk_t = q_pos // SEL_BLOCK
    j = jnp.arange(n_sel)[None, :]
    forced = (j == 0) | (j == blk_t[:, None]) | (j == blk_t[:, None] - 1)
    causal = sel_start[None, :] <= q_pos[:, None]
    score = jnp.where(forced[:, None, :], BIG, jnp.where(causal[:, None, :], importance, -BIG))
    n_top = min(TOP_N, n_sel)
    _, sel = lax.top_k(score, n_top)
    b_idx = jnp.arange(bn)[:, None, None, None]
    n_keys = n_top * SEL_BLOCK
    ks_g = ks_blk[b_idx, h_idx, sel].reshape(bn, tq, N_KV_HEADS, n_keys, HEAD_DIM)
    vs_g = vs_blk[b_idx, h_idx, sel].reshape(bn, tq, N_KV_HEADS, n_keys, HEAD_DIM)
    kpos = (sel[..., None] * SEL_BLOCK + jnp.arange(SEL_BLOCK)).reshape(bn, tq, N_KV_HEADS, n_keys)
    dist_s = q_pos[None, :, None, None] - kpos
    bias_s = jnp.moveaxis(bias_tab[t5_bucket(dist_s), h_idx], -1, 3)
    logit_s = jnp.einsum('bqhgd,bqhkd->bqhgk', q, ks_g).astype(f32) + bias_s
    p_s = masked_softmax(logit_s, (dist_s >= 0)[:, :, :, None, :])
    o_s = jnp.einsum('bqhgk,bqhkd->bqhgd', p_s.astype(vs_g.dtype), vs_g)
    dist_w = q_pos[:, None] - win_pos[None, :]
    mask_w = (dist_w >= 0) & (dist_w <= WINDOW) & (win_pos[None, :] >= 0)
    bias_w = jnp.transpose(bias_tab[t5_bucket(dist_w)], (0, 2, 3, 1))
    logit_w = jnp.einsum('bqhgd,bkhd->bqhgk', q, kv_win[:, :, 0]).astype(f32) + bias_w
    p_w = masked_softmax(logit_w, mask_w[:, None, None, :])
    o_w = jnp.einsum('bqhgk,bkhd->bqhgd', p_w.astype(kv_win.dtype), kv_win[:, :, 1])
    return gates[..., 0:1] * o_c + gates[..., 1:2] * o_s + gates[..., 2:3] * o_w


def s5_branch(u, s0_re, s0_im, lam_re, lam_im, log_dt, b_re, b_im, c_re, c_im, d_skip, w_glu):
    f32 = jnp.float32
    bn, t_len, _ = u.shape
    uf = u.astype(f32)
    ug = uf.reshape(bn, t_len, N_SSM_GROUPS, SSM_GROUP_CH)
    dt = jnp.exp(log_dt.astype(f32))[:, None]
    lr, li = lam_re.astype(f32), lam_im.astype(f32)
    mag = jnp.exp(lr * dt)
    ab_re, ab_im = mag * jnp.cos(li * dt), mag * jnp.sin(li * dt)
    den = lr * lr + li * li
    f_re = ((ab_re - 1.0) * lr + ab_im * li) / den
    f_im = (ab_im * lr - (ab_re - 1.0) * li) / den
    br, bi = b_re.astype(f32), b_im.astype(f32)
    bb_re = f_re[:, :, None] * br - f_im[:, :, None] * bi
    bb_im = f_re[:, :, None] * bi + f_im[:, :, None] * br
    bu_re = jnp.einsum('btgc,gpc->btgp', ug, bb_re)
    bu_im = jnp.einsum('btgc,gpc->btgp', ug, bb_im)
    bu_re = bu_re.at[:, 0].add(ab_re * s0_re.astype(f32) - ab_im * s0_im.astype(f32))
    bu_im = bu_im.at[:, 0].add(ab_re * s0_im.astype(f32) + ab_im * s0_re.astype(f32))
    a_re = jnp.broadcast_to(ab_re, bu_re.shape)
    a_im = jnp.broadcast_to(ab_im, bu_im.shape)

    def combine(e1, e2):
        a1r, a1i, b1r, b1i = e1
        a2r, a2i, b2r, b2i = e2
        return (a1r * a2r - a1i * a2i, a1r * a2i + a1i * a2r,
                a2r * b1r - a2i * b1i + b2r, a2r * b1i + a2i * b1r + b2i)

    _, _, s_re, s_im = lax.associative_scan(combine, (a_re, a_im, bu_re, bu_im), axis=1)
    y = (jnp.einsum('btgp,gcp->btgc', s_re, c_re.astype(f32))
         - jnp.einsum('btgp,gcp->btgc', s_im, c_im.astype(f32)))
    y = jax.nn.gelu(y.reshape(bn, t_len, SSM_WIDTH) + d_skip.astype(f32) * uf)
    y = y * jax.nn.sigmoid(y @ w_glu.astype(f32))
    return y.astype(u.dtype), s_re[:, -1], s_im[:, -1]


def split_projection(h, w_in):
    bn, t_len, _ = h.shape
    q, kv_c, kv_s, kv_w, nsa_g, u, mg = jnp.split(h @ w_in, list(SPLIT_POINTS), axis=-1)
    q = q.reshape(bn, t_len, N_KV_HEADS, GROUP, HEAD_DIM)
    nsa_g = jax.nn.sigmoid(nsa_g).reshape(bn, t_len, N_KV_HEADS, GROUP, 3)
    kv_shape = (bn, t_len, 2, N_KV_HEADS, HEAD_DIM)
    return q, kv_c.reshape(kv_shape), kv_s.reshape(kv_shape), kv_w.reshape(kv_shape), nsa_g, u, mg


def merge_branches(attn_o, ssm_o, mg, w_branch_attn, w_branch_ssm, w_out):
    g_a, g_s = jnp.split(jax.nn.sigmoid(mg), 2, axis=-1)
    return (g_a * (attn_o @ w_branch_attn) + g_s * (ssm_o @ w_branch_ssm)) @ w_out


def mixer_prompt(h, w_in, cmp_params, rel_bias, ssm_params, w_branch_attn, w_branch_ssm, w_out):
    bn, t_len, _ = h.shape
    q, kv_c, kv_s, kv_w, nsa_g, u, mg = split_projection(h, w_in)
    ctx = nsa_context(kv_c, kv_s, cmp_params)
    n_blk = t_len // Q_BLOCK
    q_blk = jnp.moveaxis(q.reshape(bn, n_blk, Q_BLOCK, N_KV_HEADS, GROUP, HEAD_DIM), 1, 0)
    g_blk = jnp.moveaxis(nsa_g.reshape(bn, n_blk, Q_BLOCK, N_KV_HEADS, GROUP, 3), 1, 0)
    kv_w_pad = jnp.pad(kv_w, ((0, 0), (WINDOW, 0), (0, 0), (0, 0), (0, 0)))

    def one_block(args):
        blk, qb, gb = args
        start = blk * Q_BLOCK
        kvb = lax.dynamic_slice_in_dim(kv_w_pad, start, Q_BLOCK + WINDOW, axis=1)
        q_pos = start + jnp.arange(Q_BLOCK)
        win_pos = start - WINDOW + jnp.arange(Q_BLOCK + WINDOW)
        return nsa_queries(qb, gb, q_pos, ctx, kvb, win_pos, rel_bias)

    o = lax.map(one_block, (jnp.arange(n_blk), q_blk, g_blk))
    attn_o = jnp.moveaxis(o, 0, 1).reshape(bn, t_len, ATTN_WIDTH)
    s0 = jnp.zeros((bn, N_SSM_GROUPS, SSM_STATE), jnp.float32)
    ssm_o, s_re, s_im = s5_branch(u, s0, s0, *ssm_params)
    out = merge_branches(attn_o, ssm_o, mg, w_branch_attn, w_branch_ssm, w_out)
    win_keep = min(WINDOW, t_len)
    return out, kv_c, kv_s, kv_w[:, t_len - win_keep:], s_re, s_im


def mixer_sample(h, cache_kv_cmp, cache_kv_sel, state_kv_win, s0_re, s0_im, page_table,
                 w_in, cmp_params, rel_bias, ssm_params, w_branch_attn, w_branch_ssm, w_out):
    bn, s_len, _ = h.shape
    q, kv_c, kv_s, kv_w, nsa_g, u, mg = split_projection(h, w_in)
    past_len = page_table.shape[1] * PAGE_SIZE
    past_c = cache_kv_cmp[page_table].reshape(bn, past_len, 2, N_KV_HEADS, HEAD_DIM)
    past_s = cache_kv_sel[page_table].reshape(bn, past_len, 2, N_KV_HEADS, HEAD_DIM)
    ctx = nsa_context(jnp.concatenate([past_c, kv_c], axis=1),
                      jnp.concatenate([past_s, kv_s], axis=1), cmp_params)
    win_len = state_kv_win.shape[1]
    kv_w_all = jnp.concatenate([state_kv_win, kv_w], axis=1)
    q_pos = past_len + jnp.arange(s_len)
    win_pos = past_len - win_len + jnp.arange(win_len + s_len)
    o = nsa_queries(q, nsa_g, q_pos, ctx, kv_w_all, win_pos, rel_bias)
    attn_o = o.reshape(bn, s_len, ATTN_WIDTH)
    ssm_o, s_re, s_im = s5_branch(u, s0_re, s0_im, *ssm_params)
    out = merge_branches(attn_o, ssm_o, mg, w_branch_attn, w_branch_ssm, w_out)
    return out, kv_c, kv_s, kv_w_all[:, s_len:], s_re, s_im


def setup_inputs(seed: int = 0) -> dict:
    key = jax.random.key(seed)
    ks = iter(jax.random.split(key, 64))
    f32 = jnp.float32

    def nrm(shape, scale):
        return jax.random.normal(next(ks), shape, f32) * scale

    def gain(shape):
        return 1.0 + nrm(shape, 0.02)

    n_pages = PAST_LEN // PAGE_SIZE
    n_phys = (DEC_BATCH * n_pages * 5) // 4
    win_buf = min(WINDOW, PAST_LEN)
    page_table = jax.random.permutation(next(ks), n_phys)[: DEC_BATCH * n_pages]
    page_table = page_table.reshape(DEC_BATCH, n_pages).astype(jnp.int32)
    lam_im = jnp.pi * jnp.arange(SSM_STATE, dtype=f32)
    kv_row = (2, N_KV_HEADS, HEAD_DIM)
    return {
        'x_prompt': nrm((BATCH, SEQ, D_MODEL), 1.0),
        'x_sample': nrm((DEC_BATCH, DEC_SEQ, D_MODEL), 1.0),
        'cache_kv_cmp': nrm((DEPTH, n_phys, PAGE_SIZE) + kv_row, 1.0),
        'cache_kv_sel': nrm((DEPTH, n_phys, PAGE_SIZE) + kv_row, 1.0),
        'state_kv_win': nrm((DEPTH, DEC_BATCH, win_buf) + kv_row, 1.0),
        'state_ssm_re': nrm((DEPTH, DEC_BATCH, N_SSM_GROUPS, SSM_STATE), 0.5),
        'state_ssm_im': nrm((DEPTH, DEC_BATCH, N_SSM_GROUPS, SSM_STATE), 0.5),
        'page_table': page_table,
        'p_prompt': nrm((DEPTH, BATCH, SEQ, PLE_DIM), 1.0),
        'p_sample': nrm((DEPTH, DEC_BATCH, DEC_SEQ, PLE_DIM), 1.0),
        'rel_bias': nrm((NUM_BUCKETS, N_HEADS), 0.5),
        'g_ffn1': gain((DEPTH, D_MODEL)),
        'w_ffn1_gate': nrm((DEPTH, D_MODEL, D_FF), D_MODEL ** -0.5),
        'w_ffn1_up': nrm((DEPTH, D_MODEL, D_FF), D_MODEL ** -0.5),
        'w_ffn1_down': nrm((DEPTH, D_FF, D_MODEL), D_FF ** -0.5),
        'g_mix': gain((DEPTH, D_MODEL)),
        'w_in': nrm((DEPTH, D_MODEL, IN_WIDTH), D_MODEL ** -0.5),
        'cmp_pos_k': nrm((DEPTH, CMP_BLOCK, HEAD_DIM), 0.1),
        'cmp_w1_k': nrm((DEPTH, CMP_BLOCK * HEAD_DIM, CMP_HIDDEN), (CMP_BLOCK * HEAD_DIM) ** -0.5),
        'cmp_b1_k': nrm((DEPTH, CMP_HIDDEN), 0.01),
        'cmp_w2_k': nrm((DEPTH, CMP_HIDDEN, HEAD_DIM), CMP_HIDDEN ** -0.5),
        'cmp_pos_v': nrm((DEPTH, CMP_BLOCK, HEAD_DIM), 0.1),
        'cmp_w1_v': nrm((DEPTH, CMP_BLOCK * HEAD_DIM, CMP_HIDDEN), (CMP_BLOCK * HEAD_DIM) ** -0.5),
        'cmp_b1_v': nrm((DEPTH, CMP_HIDDEN), 0.01),
        'cmp_w2_v': nrm((DEPTH, CMP_HIDDEN, HEAD_DIM), CMP_HIDDEN ** -0.5),
        'ssm_lambda_re': -0.5 + nrm((DEPTH, N_SSM_GROUPS, SSM_STATE), 0.01),
        'ssm_lambda_im': lam_im + nrm((DEPTH, N_SSM_GROUPS, SSM_STATE), 0.01),
        'ssm_log_dt': jax.random.uniform(next(ks), (DEPTH, N_SSM_GROUPS), f32,
                                         minval=math.log(DT_MIN), maxval=math.log(DT_MAX)),
        'ssm_b_re': nrm((DEPTH, N_SSM_GROUPS, SSM_STATE, SSM_GROUP_CH), (2 * SSM_GROUP_CH) ** -0.5),
        'ssm_b_im': nrm((DEPTH, N_SSM_GROUPS, SSM_STATE, SSM_GROUP_CH), (2 * SSM_GROUP_CH) ** -0.5),
        'ssm_c_re': nrm((DEPTH, N_SSM_GROUPS, SSM_GROUP_CH, SSM_STATE), (2 * SSM_STATE) ** -0.5),
        'ssm_c_im': nrm((DEPTH, N_SSM_GROUPS, SSM_GROUP_CH, SSM_STATE), (2 * SSM_STATE) ** -0.5),
        'ssm_d': nrm((DEPTH, SSM_WIDTH), 1.0),
        'w_glu': nrm((DEPTH, SSM_WIDTH, SSM_WIDTH), SSM_WIDTH ** -0.5),
        'w_branch_attn': nrm((DEPTH, ATTN_WIDTH, D_MODEL), ATTN_WIDTH ** -0.5),
        'w_branch_ssm': nrm((DEPTH, SSM_WIDTH, D_MODEL), SSM_WIDTH ** -0.5),
        'w_out': nrm((DEPTH, D_MODEL, D_MODEL), D_MODEL ** -0.5),
        'g_ffn2': gain((DEPTH, D_MODEL)),
        'w_ffn2_gate': nrm((DEPTH, D_MODEL, D_FF), D_MODEL ** -0.5),
        'w_ffn2_up': nrm((DEPTH, D_MODEL, D_FF), D_MODEL ** -0.5),
        'w_ffn2_down': nrm((DEPTH, D_FF, D_MODEL), D_FF ** -0.5),
        'g_ple': gain((DEPTH, D_MODEL)),
        'w_ple_gate': nrm((DEPTH, D_MODEL, D_MODEL), D_MODEL ** -0.5),
        'w_ple_proj': nrm((DEPTH, PLE_DIM, D_MODEL), PLE_DIM ** -0.5),
        'g_final': gain((D_MODEL,)),
    }


def reference(x_prompt, x_sample, cache_kv_cmp, cache_kv_sel, state_kv_win, state_ssm_re, state_ssm_im,
              page_table, p_prompt, p_sample, rel_bias,
              g_ffn1, w_ffn1_gate, w_ffn1_up, w_ffn1_down, g_mix, w_in,
              cmp_pos_k, cmp_w1_k, cmp_b1_k, cmp_w2_k, cmp_pos_v, cmp_w1_v, cmp_b1_v, cmp_w2_v,
              ssm_lambda_re, ssm_lambda_im, ssm_log_dt, ssm_b_re, ssm_b_im, ssm_c_re, ssm_c_im, ssm_d, w_glu,
              w_branch_attn, w_branch_ssm, w_out, g_ffn2, w_ffn2_gate, w_ffn2_up, w_ffn2_down,
              g_ple, w_ple_gate, w_ple_proj, g_final):
    xp, xs = x_prompt, x_sample
    kvc_p, kvs_p, kvw_p, sre_p, sim_p = [], [], [], [], []
    kvc_s, kvs_s, kvw_s, sre_s, sim_s = [], [], [], [], []
    for i in range(DEPTH):
        ffn1 = (g_ffn1[i], w_ffn1_gate[i], w_ffn1_up[i], w_ffn1_down[i])
        ffn2 = (g_ffn2[i], w_ffn2_gate[i], w_ffn2_up[i], w_ffn2_down[i])
        cmp_params = (cmp_pos_k[i], cmp_w1_k[i], cmp_b1_k[i], cmp_w2_k[i],
                      cmp_pos_v[i], cmp_w1_v[i], cmp_b1_v[i], cmp_w2_v[i])
        ssm_params = (ssm_lambda_re[i], ssm_lambda_im[i], ssm_log_dt[i], ssm_b_re[i], ssm_b_im[i],
                      ssm_c_re[i], ssm_c_im[i], ssm_d[i], w_glu[i])
        xp = half_ffn(xp, *ffn1)
        xs = half_ffn(xs, *ffn1)
        mp, c_p, s_p, w_p, r_p, m_p = mixer_prompt(rmsnorm(xp, g_mix[i]), w_in[i], cmp_params, rel_bias,
                                                   ssm_params, w_branch_attn[i], w_branch_ssm[i], w_out[i])
        ms, c_s, s_s, w_s, r_s, m_s = mixer_sample(rmsnorm(xs, g_mix[i]), cache_kv_cmp[i], cache_kv_sel[i],
                                                   state_kv_win[i], state_ssm_re[i], state_ssm_im[i], page_table,
                                                   w_in[i], cmp_params, rel_bias, ssm_params,
                                                   w_branch_attn[i], w_branch_ssm[i], w_out[i])
        xp = xp + mp
        xs = xs + ms
        xp = half_ffn(xp, *ffn2)
        xs = half_ffn(xs, *ffn2)
        xp = ple_add(xp, p_prompt[i], g_ple[i], w_ple_gate[i], w_ple_proj[i])
        xs = ple_add(xs, p_sample[i], g_ple[i], w_ple_gate[i], w_ple_proj[i])
        kvc_p.append(c_p); kvs_p.append(s_p); kvw_p.append(w_p); sre_p.append(r_p); sim_p.append(m_p)
        kvc_s.append(c_s); kvs_s.append(s_s); kvw_s.append(w_s); sre_s.append(r_s); sim_s.append(m_s)
    y_prompt = rmsnorm(xp, g_final)
    y_sample = rmsnorm(xs, g_final)
    return (y_prompt, y_sample,
            jnp.stack(kvc_p), jnp.stack(kvs_p), jnp.stack(kvw_p), jnp.stack(sre_p), jnp.stack(sim_p),
            jnp.stack(kvc_s), jnp.stack(kvs_s), jnp.stack(kvw_s), jnp.stack(sre_s), jnp.stack(sim_s))
```

```cpp
#include <hip/hip_runtime.h>
#include <hip/hip_cooperative_groups.h>
#include <cstdio>
#include <cstdint>
#include <cmath>
namespace cg = cooperative_groups;

#define LAS __attribute__((address_space(3)))
#define GAS __attribute__((address_space(1)))
typedef unsigned short bf16;
typedef short bf16x8 __attribute__((ext_vector_type(8)));
typedef short s16x4 __attribute__((ext_vector_type(4)));
typedef float f32x4 __attribute__((ext_vector_type(4)));
typedef float f32x2 __attribute__((ext_vector_type(2)));
typedef float f32x16 __attribute__((ext_vector_type(16)));
typedef unsigned u32x4 __attribute__((ext_vector_type(4)));
typedef unsigned u32x2 __attribute__((ext_vector_type(2)));

constexpr int DM = 1024, NP = 16384, NSR = 512, MR = NP + NSR;
constexpr int SEQ = 2048, NB = 8, DB = 128, DS = 4, PAST = 2048, NBA = DB + NB;
constexpr int FF = 2816, NIN = 4096, PLE = 256;
constexpr int NWAVES = 8, NTHREADS = 512;
constexpr float RMS_EPS = 1e-6f;
constexpr float LOG2E = 1.4426950408889634f;

constexpr size_t O_YP = 0, O_YS = O_YP + (size_t)NP * DM, O_KVCP = O_YS + (size_t)NSR * DM, O_KVSP = O_KVCP + (size_t)NP * 256, O_KVWP = O_KVSP + (size_t)NP * 256,
                 O_SREP = O_KVWP + (size_t)NB * 512 * 256, O_SIMP = O_SREP + NB * 32 * 64, O_KVCS = O_SIMP + NB * 32 * 64, O_KVSS = O_KVCS + (size_t)NSR * 256,
                 O_KVWS = O_KVSS + (size_t)NSR * 256, O_SRES = O_KVWS + (size_t)DB * 512 * 256, O_SIMS = O_SRES + DB * 32 * 64, O_END = O_SIMS + DB * 32 * 64;

constexpr size_t al256(size_t x) { return (x + 255) & ~(size_t)255; }
constexpr size_t WS_CTL = 0, CTL_BYTES = 2u << 20;
constexpr size_t WS_SSQ = 65536;
constexpr size_t WS_SSQ0 = CTL_BYTES;
constexpr size_t WS_WGU1 = al256(WS_SSQ0 + (size_t)MR * 4);
constexpr size_t WS_WD1 = WS_WGU1 + (size_t)2 * FF * DM * 2;
constexpr size_t WS_WIN = WS_WD1 + (size_t)DM * FF * 2;
constexpr size_t WS_WGLU = WS_WIN + (size_t)NIN * DM * 2;
constexpr size_t WS_WBA = WS_WGLU + (size_t)512 * 512 * 2;
constexpr size_t WS_WBS = WS_WBA + (size_t)DM * 512 * 2;
constexpr size_t WS_WOUT = WS_WBS + (size_t)DM * 512 * 2;
constexpr size_t WS_WGU2 = WS_WOUT + (size_t)DM * DM * 2;
constexpr size_t WS_WD2 = WS_WGU2 + (size_t)2 * FF * DM * 2;
constexpr size_t WS_WPG = WS_WD2 + (size_t)DM * FF * 2;
constexpr size_t WS_WPP = WS_WPG + (size_t)DM * DM * 2;
constexpr size_t WS_WC1 = WS_WPP + (size_t)DM * PLE * 2;
constexpr size_t WS_WC2 = WS_WC1 + (size_t)2 * 256 * 1024 * 2;
constexpr size_t WS_XB = al256(WS_WC2 + (size_t)2 * 64 * 128 * 2);
constexpr size_t WS_XR = WS_XB + (size_t)MR * DM * 2;
constexpr size_t WS_H = WS_XR + (size_t)MR * DM * 4;
constexpr size_t WS_Q = WS_H + (size_t)MR * FF * 2;
constexpr size_t WS_KVS = WS_Q + (size_t)MR * 512 * 2;
constexpr size_t WS_KVW = WS_KVS + (size_t)MR * 256 * 2;
constexpr size_t WS_U = WS_KVW + (size_t)MR * 256 * 2;
constexpr size_t WS_NG = WS_U + (size_t)MR * 512 * 2;
constexpr size_t WS_MG = al256(WS_NG + (size_t)MR * 24 * 4);
constexpr size_t WS_AO = WS_MG + (size_t)MR * 2048 * 2;
constexpr size_t WS_YG = WS_AO + (size_t)MR * DM * 2;
constexpr size_t WS_T1 = WS_YG + (size_t)MR * 512 * 2;
constexpr size_t WS_TT = WS_T1 + (size_t)MR * DM * 4;
constexpr size_t WS_PP = WS_TT + (size_t)MR * DM * 2;
constexpr size_t WS_PB = WS_PP + (size_t)MR * DM * 2;
constexpr size_t WS_CCB = WS_PB + (size_t)MR * PLE * 2;
constexpr size_t WS_OUTC = WS_CCB + (size_t)NBA * 2048 * 256 * 2;
constexpr size_t WS_KC = WS_OUTC + (size_t)4 * NBA * 128 * 256 * 2;
constexpr size_t WS_VC = WS_KC + (size_t)NBA * 2 * 128 * 64 * 2;
constexpr size_t WS_TZ = WS_VC + (size_t)NBA * 2 * 128 * 64 * 2;
constexpr size_t WS_PT = WS_TZ + (size_t)32 * 512 * 512 * 2;
constexpr size_t WS_WC = WS_PT + (size_t)32 * 128 * 512 * 2;
constexpr size_t WS_ABT = WS_WC + (size_t)32 * 512 * 128 * 2;
constexpr size_t WS_ABL = WS_ABT + 32 * 64 * 2 * 4;
constexpr size_t WS_BBT = WS_ABL + 32 * 64 * 2 * 4;
constexpr size_t WS_BIAS = WS_BBT + 32 * 64 * 16 * 2 * 4;
constexpr size_t WS_CCON = 32768;
constexpr size_t WS_END = al256(WS_BIAS + 8 * 136 * 4);

__device__ __forceinline__ unsigned f2bf(float f) { unsigned u = __builtin_bit_cast(unsigned, f); return (u + 0x7fffu + ((u >> 16) & 1u)) >> 16; }
__device__ __forceinline__ unsigned pk2(float lo, float hi) {
    typedef __bf16 bf16x2_t __attribute__((ext_vector_type(2)));
    f32x2 v = {lo, hi}; bf16x2_t b = __builtin_convertvector(v, bf16x2_t); return __builtin_bit_cast(unsigned, b); }
__device__ __forceinline__ float bflo(unsigned w) { return __builtin_bit_cast(float, w << 16); }
__device__ __forceinline__ float bfhi(unsigned w) { return __builtin_bit_cast(float, w & 0xffff0000u); }
__device__ __forceinline__ float bf2f(bf16 h) { return __builtin_bit_cast(float, (unsigned)h << 16); }
__device__ __forceinline__ float fast_exp2(float x) { return __builtin_amdgcn_exp2f(x); }
__device__ __forceinline__ float fast_rcp(float x) { return __builtin_amdgcn_rcpf(x); }
__device__ __forceinline__ float sigmoidf_(float x) { return fast_rcp(1.0f + fast_exp2(-x * LOG2E)); }
__device__ __forceinline__ float siluf_(float x) { return x * sigmoidf_(x); }
__device__ __forceinline__ float gelu_tanh(float x) { const float z = 0.7978845608028654f * (x + 0.044715f * x * x * x); return x * fast_rcp(1.0f + fast_exp2(-2.0f * LOG2E * z)); }
__device__ __forceinline__ float rstd_of(float ssq) { return 1.0f / sqrtf(ssq * (1.0f / DM) + RMS_EPS); }
#define LDS_WAIT() asm volatile("s_waitcnt lgkmcnt(0)" ::: "memory")
#ifndef MK_ONE_LAUNCH
#define MK_ONE_LAUNCH 1
#endif
namespace pg8 {
#define PG8_LAS __attribute__((address_space(3)))
typedef unsigned short bf16_t;
typedef short bf16x8 __attribute__((ext_vector_type(8)));
typedef float f32x4 __attribute__((ext_vector_type(4)));
typedef unsigned u32x4 __attribute__((ext_vector_type(4)));
constexpr int BM = 256, BK = 64, HALF = 128, HTB = HALF * BK * 2  , STAGE_BYTES = 8 * HTB, NXCD = 8, WGM = 8;

__host__ __device__ __forceinline__ int lds_byte(int r, int c) { const int st = (r >> 4) * 2 + (c >> 5), rr = r & 15, cc = c & 31, ob = rr * 64 + cc * 2; return st * 1024 + (ob ^ (((ob >> 9) & 1) << 5)); }
__host__ __device__ __forceinline__ void stage_rc(int b, int& R, int& C) { const int st = b / 1024, sb = b % 1024, swz = sb ^ (((sb >> 9) & 1) << 5); R = (st >> 1) * 16 + swz / 64; C = (st & 1) * 32 + (swz % 64) / 2; }
__host__ __device__ __forceinline__ int perm32(int rho) { const int n = rho >> 4, i = rho & 15; return 8 * (i >> 2) + 4 * n + (i & 3); }

struct Unit { int pm, pn, kt0, nt; };
struct Gemm { const bf16_t* A; const bf16_t* Bt; int M, N, K; int lda, kstepA; int vt, vstride, bdiv;
    __device__ __forceinline__ const char* a_tile(const Unit& u) const {
        const size_t off = vt ? (size_t)(u.pm / vt) * vstride + (size_t)(u.pm % vt) * 256 * lda : (size_t)u.pm * 256 * lda; return (const char*)(A + off + (size_t)u.kt0 * kstepA); }
    __device__ __forceinline__ const char* b_tile(const Unit& u) const { const int bi = bdiv ? u.pm / bdiv : u.pn; return (const char*)(Bt + (size_t)bi * 256 * K + (size_t)u.kt0 * BK); }
};

struct StaticOrder {
    int nM, nN, nwg, G, c, nMf, split, ntf, nfull;
    __host__ __device__ void init(int M, int N, int G_, int c_, int K = 0, int Mfull = -1, int split_ = 1) { nM = M / BM; nN = N / BM; G = G_; c = c_; ntf = K / BK;
        nMf = Mfull < 0 ? nM : Mfull / BM; split = split_; nfull = nMf * nN; nwg = nfull + (nM - nMf) * nN * split; }
    __host__ __device__ bool next(int i, Unit& u) const {
        const long L = (long)i * G + c; if (L >= nwg) return false;
        const bool sp = L >= nfull;
        const int idx = (int)L - nfull, per = nN * split, rem = idx % per, snt = ntf / split;
        int wgid = (int)L; { const int q = nfull / NXCD, r = nfull % NXCD, xcd = wgid % NXCD, off = wgid / NXCD; wgid = (xcd < r ? xcd * (q + 1) : r * (q + 1) + (xcd - r) * q) + off; }
        const int nig = WGM * nN, gid = wgid / nig, fm = gid * WGM, gsz = (nMf - fm) < WGM ? (nMf - fm) : WGM;
        const int fpm = fm + ((wgid % nig) % (gsz > 0 ? gsz : 1)), fpn = (wgid % nig) / (gsz > 0 ? gsz : 1);
        Unit r; r.pm = sp ? nMf + idx / per : fpm; r.pn = sp ? rem / split : fpn; r.kt0 = sp ? (rem % split) * snt : 0; r.nt = sp ? snt : ntf; u = r; return true;
    }
    __device__ __forceinline__ void a_ready(const Unit&) const {}
    __device__ __forceinline__ void done(const Unit&) const {}
};

typedef const f32x4 (&AccRef)[2][2][4][2];
#define EPI_ROW(ai, m) (u.pm * BM + (ai) * HALF + wr * 64 + (m) * 16 + fr)
#define EPI_COL(bj) (u.pn * BM + (bj) * HALF + wc * 32 + 8 * fq)
__device__ __forceinline__ u32x4 pack8(f32x4 a, f32x4 b) { u32x4 w; w.x = pk2(a[0], a[1]); w.y = pk2(a[2], a[3]); w.z = pk2(b[0], b[1]); w.w = pk2(b[2], b[3]); return w; }
__device__ __forceinline__ void unpack8(u32x4 w, f32x4& a, f32x4& b) { a = (f32x4){bflo(w.x), bfhi(w.x), bflo(w.y), bfhi(w.y)}; b = (f32x4){bflo(w.z), bfhi(w.z), bflo(w.w), bfhi(w.w)}; }

struct EpiPlain {
    static constexpr bool PERM = true, AFTER_DRAIN = false, MIDK = false;
    bf16_t* O; int ldo;
    __device__ __forceinline__ void operator()(AccRef acc, const Unit& u, int wr, int wc, int fr, int fq) const {
#pragma unroll
        for (int ai = 0; ai < 2; ++ai)
#pragma unroll
            for (int m = 0; m < 4; ++m) { bf16_t* rowp = O + (size_t)EPI_ROW(ai, m) * ldo;
#pragma unroll
                for (int bj = 0; bj < 2; ++bj) *(u32x4*)(rowp + EPI_COL(bj)) = pack8(acc[ai][bj][m][0], acc[ai][bj][m][1]); }
    }
};
struct EpiSwiglu {
    static constexpr bool PERM = true, AFTER_DRAIN = false, MIDK = false;
    bf16_t* H; int ldo; const float* ssq;
    __device__ __forceinline__ void operator()(AccRef acc, const Unit& u, int wr, int wc, int fr, int fq) const {
        const int col = u.pn * HALF + wc * 32 + 8 * fq;
#pragma unroll
        for (int ai = 0; ai < 2; ++ai)
#pragma unroll
            for (int m = 0; m < 4; ++m) { const int row = EPI_ROW(ai, m); const float rs = rstd_of(ssq[row]);
                f32x4 h0, h1;
#pragma unroll
                for (int e = 0; e < 4; ++e) { h0[e] = siluf_(acc[ai][0][m][0][e] * rs) * (acc[ai][1][m][0][e] * rs); h1[e] = siluf_(acc[ai][0][m][1][e] * rs) * (acc[ai][1][m][1][e] * rs); }
                *(u32x4*)(H + (size_t)row * ldo + col) = pack8(h0, h1); asm volatile("" ::: "memory"); }
    }
};
struct EpiResid {
    static constexpr bool PERM = true, AFTER_DRAIN = false, MIDK = false;
    const float* baseP; const float* baseS; float* xr; bf16_t* xb; float* ssq_out; float scale; float* part;
    __device__ __forceinline__ void operator()(AccRef acc, const Unit& u, int wr, int wc, int fr, int fq) const {
        if (part && u.pm >= NP / BM) { const int ks = u.kt0 / u.nt;
#pragma unroll
            for (int ai = 0; ai < 2; ++ai)
#pragma unroll
                for (int m = 0; m < 4; ++m) { float* pr = part + ((size_t)ks * NSR + (EPI_ROW(ai, m) - NP)) * DM;
#pragma unroll
                    for (int bj = 0; bj < 2; ++bj) { const int col = EPI_COL(bj); *(f32x4*)(pr + col) = acc[ai][bj][m][0]; *(f32x4*)(pr + col + 4) = acc[ai][bj][m][1]; } }
            return; }
#pragma unroll
        for (int ai = 0; ai < 2; ++ai)
#pragma unroll
            for (int m = 0; m < 4; ++m) { const int row = EPI_ROW(ai, m);
                const float* bp = row < NP ? baseP + (size_t)row * DM : baseS + (size_t)(row - NP) * DM; float ss = 0.f;
#pragma unroll
                for (int bj = 0; bj < 2; ++bj) { const int col = EPI_COL(bj);
                    const f32x4 o0 = *(const f32x4*)(bp + col), o1 = *(const f32x4*)(bp + col + 4);
                    const f32x4 n0 = o0 + acc[ai][bj][m][0] * scale, n1 = o1 + acc[ai][bj][m][1] * scale;
                    *(f32x4*)(xr + (size_t)row * DM + col) = n0; *(f32x4*)(xr + (size_t)row * DM + col + 4) = n1;
                    *(u32x4*)(xb + (size_t)row * DM + col) = pack8(n0, n1);
                    ss += (n0[0] * n0[0] + n0[1] * n0[1]) + (n0[2] * n0[2] + n0[3] * n0[3]) + (n1[0] * n1[0] + n1[1] * n1[1]) + (n1[2] * n1[2] + n1[3] * n1[3]); }
                ss += __shfl_xor(ss, 16); ss += __shfl_xor(ss, 32);
                if (fq == 0) atomicAdd(ssq_out + row, ss); asm volatile("" ::: "memory"); }
    }
};
struct EpiWin {
    static constexpr bool PERM = true, AFTER_DRAIN = false, MIDK = false;
    const float* ssq; float* out; bf16_t *Q, *CCBP, *KVS, *KVW, *U, *MG; float* NG;
    __device__ __forceinline__ void operator()(AccRef acc, const Unit& u, int wr, int wc, int fr, int fq) const {
        const int pn = u.pn;
#pragma unroll
        for (int ai = 0; ai < 2; ++ai)
#pragma unroll
            for (int m = 0; m < 4; ++m) { const int row = EPI_ROW(ai, m); const float rs = rstd_of(ssq[row]);
#pragma unroll
                for (int bj = 0; bj < 2; ++bj) { const int c = bj * HALF + wc * 32 + 8 * fq;
                    f32x4 v0 = acc[ai][bj][m][0] * rs, v1 = acc[ai][bj][m][1] * rs;
                    if (pn < 2) { v0 = v0 * (0.125f * LOG2E); v1 = v1 * (0.125f * LOG2E); *(u32x4*)(Q + (size_t)row * 512 + pn * 256 + c) = pack8(v0, v1); }
                    else if (pn < 5) {
                        float* op; bool wr_out = true;
                        if (row < NP) { const int t = row & (SEQ - 1), b = row >> 11;
                            if (pn == 2) op = out + O_KVCP + (size_t)row * 256; else if (pn == 3) op = out + O_KVSP + (size_t)row * 256;
                            else { op = out + O_KVWP + (size_t)(b * 512 + (t - 1536)) * 256; wr_out = t >= 1536; } }
                        else { const int sr = row - NP, b = sr >> 2, s = sr & 3;
                            if (pn == 2) op = out + O_KVCS + (size_t)sr * 256; else if (pn == 3) op = out + O_KVSS + (size_t)sr * 256;
                            else op = out + O_KVWS + (size_t)(b * 512 + 508 + s) * 256; }
                        if (wr_out) { *(f32x4*)(op + c) = v0; *(f32x4*)(op + c + 4) = v1; }
                        const u32x4 w = pack8(v0, v1);
                        if (pn == 2) { if (row < NP) *(u32x4*)(CCBP + (size_t)row * 256 + c) = w; }
                        else if (pn == 3) *(u32x4*)(KVS + (size_t)row * 256 + c) = w;
                        else *(u32x4*)(KVW + (size_t)row * 256 + c) = w; }
                    else if (pn < 7) { *(u32x4*)(U + (size_t)row * 512 + (pn - 5) * 256 + c) = pack8(v0, v1); }
                    else if (pn < 15) { if (bj == 0) {
                        f32x4 s0 = acc[ai][1][m][0] * rs, s1 = acc[ai][1][m][1] * rs;
#pragma unroll
                        for (int e = 0; e < 4; ++e) { s0[e] = fmaxf(sigmoidf_(s0[e]), 1e-30f); s1[e] = fmaxf(sigmoidf_(s1[e]), 1e-30f); v0[e] = sigmoidf_(v0[e]) * fast_rcp(s0[e]); v1[e] = sigmoidf_(v1[e]) * fast_rcp(s1[e]); }
                        const int cg = (pn - 7) * 128 + wc * 32 + 8 * fq;
                        *(u32x4*)(MG + (size_t)row * 2048 + cg) = pack8(v0, v1); *(u32x4*)(MG + (size_t)row * 2048 + 1024 + cg) = pack8(s0, s1); } }
                    else { if (c < 24) {
#pragma unroll
                        for (int e = 0; e < 4; ++e) { v0[e] = sigmoidf_(v0[e]); v1[e] = sigmoidf_(v1[e]); }
                        *(f32x4*)(NG + (size_t)row * 24 + c) = v0; *(f32x4*)(NG + (size_t)row * 24 + c + 4) = v1; } }
                } asm volatile("" ::: "memory"); }
    }
};
struct EpiGlu {
    static constexpr bool PERM = true, AFTER_DRAIN = false, MIDK = false;
    const bf16_t* YG; bf16_t* AO;
    __device__ __forceinline__ void operator()(AccRef acc, const Unit& u, int wr, int wc, int fr, int fq) const {
#pragma unroll
        for (int ai = 0; ai < 2; ++ai)
#pragma unroll
            for (int m = 0; m < 4; ++m) { const int row = EPI_ROW(ai, m);
#pragma unroll
                for (int bj = 0; bj < 2; ++bj) { const int col = EPI_COL(bj); f32x4 y0, y1; unpack8(*(const u32x4*)(YG + (size_t)row * 512 + col), y0, y1);
#pragma unroll
                    for (int e = 0; e < 4; ++e) { y0[e] *= sigmoidf_(acc[ai][bj][m][0][e]); y1[e] *= sigmoidf_(acc[ai][bj][m][1][e]); }
                    *(u32x4*)(AO + (size_t)row * DM + 512 + col) = pack8(y0, y1); } asm volatile("" ::: "memory"); }
    }
};
struct EpiMerge {
    static constexpr bool PERM = true, AFTER_DRAIN = false, MIDK = true;
    const bf16_t* MG; bf16_t* TT;
    __device__ __forceinline__ void mid(f32x4 (&acc)[2][2][4][2], const Unit& u, int wr, int wc, int fr, int fq) const {
#pragma unroll
        for (int ai = 0; ai < 2; ++ai)
#pragma unroll
            for (int m = 0; m < 4; ++m) { const int row = EPI_ROW(ai, m);
#pragma unroll
                for (int bj = 0; bj < 2; ++bj) { const int col = EPI_COL(bj); f32x4 a0, a1; unpack8(*(const u32x4*)(MG + (size_t)row * 2048 + col), a0, a1);
                    acc[ai][bj][m][0] = acc[ai][bj][m][0] * a0; acc[ai][bj][m][1] = acc[ai][bj][m][1] * a1; }
                asm volatile("" ::: "memory"); }
    }
    __device__ __forceinline__ void operator()(AccRef acc, const Unit& u, int wr, int wc, int fr, int fq) const {
#pragma unroll
        for (int ai = 0; ai < 2; ++ai)
#pragma unroll
            for (int m = 0; m < 4; ++m) { const int row = EPI_ROW(ai, m);
#pragma unroll
                for (int bj = 0; bj < 2; ++bj) { const int col = EPI_COL(bj); f32x4 s0, s1; unpack8(*(const u32x4*)(MG + (size_t)row * 2048 + 1024 + col), s0, s1);
                    *(u32x4*)(TT + (size_t)row * DM + col) = pack8(s0 * acc[ai][bj][m][0], s1 * acc[ai][bj][m][1]); }
                asm volatile("" ::: "memory"); }
    }
};
struct EpiMerge1 {
    static constexpr bool PERM = true, AFTER_DRAIN = false, MIDK = false;
    const bf16_t* MG; float* T1;
    __device__ __forceinline__ void operator()(AccRef acc, const Unit& u, int wr, int wc, int fr, int fq) const {
#pragma unroll
        for (int ai = 0; ai < 2; ++ai)
#pragma unroll
            for (int m = 0; m < 4; ++m) { const int row = EPI_ROW(ai, m);
#pragma unroll
                for (int bj = 0; bj < 2; ++bj) { const int col = EPI_COL(bj); f32x4 g0, g1; unpack8(*(const u32x4*)(MG + (size_t)row * 2048 + col), g0, g1);
                    *(f32x4*)(T1 + (size_t)row * DM + col) = g0 * acc[ai][bj][m][0]; *(f32x4*)(T1 + (size_t)row * DM + col + 4) = g1 * acc[ai][bj][m][1]; } asm volatile("" ::: "memory"); }
    }
};
struct EpiMerge2 {
    static constexpr bool PERM = true, AFTER_DRAIN = false, MIDK = false;
    const bf16_t* MG; const float* T1; bf16_t* TT;
    __device__ __forceinline__ void operator()(AccRef acc, const Unit& u, int wr, int wc, int fr, int fq) const {
#pragma unroll
        for (int ai = 0; ai < 2; ++ai)
#pragma unroll
            for (int m = 0; m < 4; ++m) { const int row = EPI_ROW(ai, m);
#pragma unroll
                for (int bj = 0; bj < 2; ++bj) { const int col = EPI_COL(bj); f32x4 g0, g1; unpack8(*(const u32x4*)(MG + (size_t)row * 2048 + 1024 + col), g0, g1);
                    const f32x4 t0 = *(const f32x4*)(T1 + (size_t)row * DM + col) + g0 * acc[ai][bj][m][0], t1 = *(const f32x4*)(T1 + (size_t)row * DM + col + 4) + g1 * acc[ai][bj][m][1];
                    *(u32x4*)(TT + (size_t)row * DM + col) = pack8(t0, t1); } asm volatile("" ::: "memory"); }
    }
};
struct EpiPleGate {
    static constexpr bool PERM = true, AFTER_DRAIN = false, MIDK = false;
    const float* ssq; const bf16_t* PP; float* xr; float* ssq_out; float* part;
    __device__ __forceinline__ void operator()(AccRef acc, const Unit& u, int wr, int wc, int fr, int fq) const {
        if (part && u.pm >= NP / BM) { const int ks = u.kt0 / u.nt;
#pragma unroll
            for (int ai = 0; ai < 2; ++ai)
#pragma unroll
                for (int m = 0; m < 4; ++m) { float* pr = part + ((size_t)ks * NSR + (EPI_ROW(ai, m) - NP)) * DM;
#pragma unroll
                    for (int bj = 0; bj < 2; ++bj) { const int col = EPI_COL(bj); *(f32x4*)(pr + col) = acc[ai][bj][m][0]; *(f32x4*)(pr + col + 4) = acc[ai][bj][m][1]; } }
            return; }
#pragma unroll
        for (int ai = 0; ai < 2; ++ai)
#pragma unroll
            for (int m = 0; m < 4; ++m) { const int row = EPI_ROW(ai, m); const float rs = rstd_of(ssq[row]); float ss = 0.f;
#pragma unroll
                for (int bj = 0; bj < 2; ++bj) { const int col = EPI_COL(bj); f32x4 p0, p1; unpack8(*(const u32x4*)(PP + (size_t)row * DM + col), p0, p1);
                    f32x4 n0 = *(const f32x4*)(xr + (size_t)row * DM + col), n1 = *(const f32x4*)(xr + (size_t)row * DM + col + 4);
#pragma unroll
                    for (int e = 0; e < 4; ++e) { n0[e] += sigmoidf_(acc[ai][bj][m][0][e] * rs) * p0[e]; n1[e] += sigmoidf_(acc[ai][bj][m][1][e] * rs) * p1[e]; }
                    *(f32x4*)(xr + (size_t)row * DM + col) = n0; *(f32x4*)(xr + (size_t)row * DM + col + 4) = n1;
                    ss += (n0[0] * n0[0] + n0[1] * n0[1]) + (n0[2] * n0[2] + n0[3] * n0[3]) + (n1[0] * n1[0] + n1[1] * n1[1]) + (n1[2] * n1[2] + n1[3] * n1[3]); }
                ss += __shfl_xor(ss, 16); ss += __shfl_xor(ss, 32);
                if (fq == 0) atomicAdd(ssq_out + row, ss); asm volatile("" ::: "memory"); }
    }
};
template <class Epi, class Sched, bool ALIGN_EPI = false, bool SP2 = false>
__device__ __forceinline__ void gemm_phase(PG8_LAS unsigned char* lds, const Gemm g, const Sched& S, const Epi& E) {
    const int tid = threadIdx.x, wid = __builtin_amdgcn_readfirstlane(tid >> 6), lane = tid & 63, wr = wid >> 2, wc = wid & 3, fr = lane & 15, fq = lane >> 4;
    const int K = g.K;
    unsigned voffA[2], voffB[2];
#pragma unroll
    for (int i = 0; i < 2; ++i) { int R, C; stage_rc(tid * 16 + i * 8192, R, C); const int Rb = Epi::PERM ? ((R & ~31) + perm32(R & 31)) : R;
        voffA[i] = (unsigned)(R * g.lda + C) * 2u; voffB[i] = (unsigned)(Rb * K + C) * 2u; }
    const size_t kstep = (size_t)(BK * 2), kstepA = (size_t)g.kstepA * 2;
    const size_t hstep = (size_t)HALF * K * 2, hstepA = (size_t)HALF * g.lda * 2;
        const unsigned ldsw = (unsigned)wid * 1024u;
    const int aoff = lds_byte(wr * 64 + fr, fq * 8), boff = lds_byte(wc * 32 + fr, fq * 8);
#define PG8_SA(b, h) (((b) * 2 + (h)) * HTB)
#define PG8_SB(b, h) ((4 + (b) * 2 + (h)) * HTB)
#define PG8_STAGE(bufoff, gbase, voff) do { _Pragma("unroll") for (int _i = 0; _i < 2; ++_i) \
        __builtin_amdgcn_global_load_lds((const unsigned*)((const char*)(gbase) + (voff)[_i]), (PG8_LAS unsigned*)(lds + (bufoff) + ldsw + _i * 8192), 16, 0, 0); } while (0)
#define PG8_LDA(dst, b, h) do { _Pragma("unroll") for (int m = 0; m < 4; ++m) _Pragma("unroll") for (int k = 0; k < 2; ++k) dst[m][k] = *(const PG8_LAS bf16x8*)(lds + PG8_SA(b, h) + aoff + m * 2048 + k * 1024); } while (0)
#define PG8_LDB(dst, b, h) do { _Pragma("unroll") for (int n = 0; n < 2; ++n) _Pragma("unroll") for (int k = 0; k < 2; ++k) dst[n][k] = *(const PG8_LAS bf16x8*)(lds + PG8_SB(b, h) + boff + n * 2048 + k * 1024); } while (0)
#define PG8_MMA(ai, bj, At, Bt) do { __builtin_amdgcn_s_setprio(1); _Pragma("unroll") for (int m = 0; m < 4; ++m) _Pragma("unroll") for (int n = 0; n < 2; ++n) _Pragma("unroll") for (int k = 0; k < 2; ++k) \
        acc[ai][bj][m][n] = __builtin_amdgcn_mfma_f32_16x16x32_bf16(Bt[n][k], At[m][k], acc[ai][bj][m][n], 0, 0, 0); __builtin_amdgcn_s_setprio(0); } while (0)
#define PG8_WAIT_V(n) asm volatile("s_waitcnt vmcnt(" #n ")" ::: "memory")
#define PG8_WAIT_L(n) asm volatile("s_waitcnt lgkmcnt(" #n ")" ::: "memory")
#define PG8_BAR __builtin_amdgcn_s_barrier()
#define PG8_SCHED __builtin_amdgcn_sched_barrier(0)
    Unit cur, nxt; int ui = 0;
    if (!S.next(0, cur)) return;
    f32x4 acc[2][2][4][2];
#pragma unroll
    for (int a = 0; a < 2; ++a)
#pragma unroll
        for (int b = 0; b < 2; ++b)
#pragma unroll
            for (int m = 0; m < 4; ++m)
#pragma unroll
                for (int n = 0; n < 2; ++n) acc[a][b][m][n] = (f32x4){0.f, 0.f, 0.f, 0.f};
    bf16x8 At[4][2], B0[2][2], B1[2][2];
    const char* cA = g.a_tile(cur); const char* cB = g.b_tile(cur);
    S.a_ready(cur);
    if constexpr (SP2) {
        PG8_STAGE(PG8_SB(0, 0), cB, voffB); PG8_STAGE(PG8_SB(0, 1), cB + hstep, voffB); PG8_STAGE(PG8_SA(0, 0), cA, voffA); PG8_STAGE(PG8_SA(0, 1), cA + hstepA, voffA);
        if (wr == 1) PG8_BAR;
        PG8_WAIT_V(2); PG8_BAR;
        PG8_STAGE(PG8_SB(1, 0), cB + kstep, voffB); PG8_STAGE(PG8_SA(1, 0), cA + kstepA, voffA); PG8_STAGE(PG8_SB(1, 1), cB + hstep + kstep, voffB);
        PG8_WAIT_V(6); PG8_BAR;
    } else {
        PG8_STAGE(PG8_SB(0, 0), cB, voffB); PG8_STAGE(PG8_SA(0, 0), cA, voffA); PG8_STAGE(PG8_SB(0, 1), cB + hstep, voffB); PG8_STAGE(PG8_SA(0, 1), cA + hstepA, voffA);
        if (wr == 1) PG8_BAR;
        PG8_WAIT_V(4); PG8_BAR;
        PG8_STAGE(PG8_SB(1, 0), cB + kstep, voffB); PG8_STAGE(PG8_SA(1, 0), cA + kstepA, voffA); PG8_STAGE(PG8_SB(1, 1), cB + hstep + kstep, voffB);
        PG8_WAIT_V(6); PG8_BAR;
    }
    for (;;) {
        const bool has_next = S.next(ui + 1, nxt);
        const char* nA = has_next ? g.a_tile(nxt) : cA; const char* nB = has_next ? g.b_tile(nxt) : cB;
        const int nt = cur.nt;
        for (int t = 0; t < nt; t += 2) {
            const bool last = (t == nt - 2);
            const char* a1 = cA + (size_t)(t + 1) * kstepA;
            const char* a2 = last ? nA : cA + (size_t)(t + 2) * kstepA; const char* b2 = last ? nB : cB + (size_t)(t + 2) * kstep;
            const char* a3 = a2 + kstepA; const char* b3 = b2 + kstep;
            if (last && has_next) S.a_ready(nxt);
            if constexpr (Epi::MIDK) { if (t == (nt >> 1)) E.mid(acc, cur, wr, wc, fr, fq); }
            if constexpr (SP2) {
            PG8_LDB(B0, 0, 0); PG8_LDB(B1, 0, 1); PG8_SCHED; PG8_LDA(At, 0, 0); PG8_STAGE(PG8_SA(1, 1), a1 + hstepA, voffA);
            PG8_WAIT_V(8); PG8_WAIT_L(0); PG8_BAR; PG8_MMA(0, 0, At, B0); PG8_MMA(0, 1, At, B1); PG8_BAR; PG8_SCHED;
            PG8_LDA(At, 0, 1); PG8_STAGE(PG8_SB(0, 0), b2, voffB); PG8_STAGE(PG8_SB(0, 1), b2 + hstep, voffB); PG8_STAGE(PG8_SA(0, 0), a2, voffA);
            PG8_WAIT_V(8); PG8_WAIT_L(0); PG8_BAR; PG8_MMA(1, 0, At, B0); PG8_MMA(1, 1, At, B1); PG8_BAR; PG8_SCHED;
            PG8_LDB(B0, 1, 0); PG8_LDB(B1, 1, 1); PG8_SCHED; PG8_LDA(At, 1, 0); PG8_STAGE(PG8_SA(0, 1), a2 + hstepA, voffA);
            PG8_WAIT_V(8); PG8_WAIT_L(0); PG8_BAR; PG8_MMA(0, 0, At, B0); PG8_MMA(0, 1, At, B1); PG8_BAR; PG8_SCHED;
            PG8_LDA(At, 1, 1); PG8_STAGE(PG8_SB(1, 0), b3, voffB); PG8_STAGE(PG8_SB(1, 1), b3 + hstep, voffB); PG8_STAGE(PG8_SA(1, 0), a3, voffA);
            PG8_WAIT_V(8); PG8_WAIT_L(0); PG8_BAR; PG8_MMA(1, 0, At, B0); PG8_MMA(1, 1, At, B1); PG8_BAR; PG8_SCHED;
            } else {
            PG8_LDB(B0, 0, 0); PG8_SCHED; PG8_LDA(At, 0, 0); PG8_STAGE(PG8_SA(1, 1), a1 + hstepA, voffA);
            PG8_WAIT_L(8); PG8_BAR; PG8_WAIT_L(0); PG8_MMA(0, 0, At, B0); PG8_BAR; PG8_SCHED;
            PG8_LDB(B1, 0, 1); PG8_STAGE(PG8_SB(0, 0), b2, voffB);
            PG8_BAR; PG8_WAIT_L(0); PG8_MMA(0, 1, At, B1); PG8_BAR;
            PG8_LDA(At, 0, 1); PG8_STAGE(PG8_SA(0, 0), a2, voffA);
            PG8_BAR; PG8_WAIT_L(0); PG8_MMA(1, 0, At, B0); PG8_BAR; PG8_SCHED;
            PG8_STAGE(PG8_SB(0, 1), b2 + hstep, voffB);
            PG8_WAIT_V(6); PG8_BAR; PG8_MMA(1, 1, At, B1); PG8_BAR;
            PG8_LDB(B0, 1, 0); PG8_SCHED; PG8_LDA(At, 1, 0); PG8_STAGE(PG8_SA(0, 1), a2 + hstepA, voffA);
            PG8_WAIT_L(8); PG8_BAR; PG8_WAIT_L(0); PG8_MMA(0, 0, At, B0); PG8_BAR; PG8_SCHED;
            PG8_LDB(B1, 1, 1); PG8_STAGE(PG8_SB(1, 0), b3, voffB);
            PG8_BAR; PG8_WAIT_L(0); PG8_MMA(0, 1, At, B1); PG8_BAR;
            PG8_LDA(At, 1, 1); PG8_STAGE(PG8_SA(1, 0), a3, voffA);
            PG8_BAR; PG8_WAIT_L(0); PG8_MMA(1, 0, At, B0); PG8_BAR; PG8_SCHED;
            PG8_STAGE(PG8_SB(1, 1), b3 + hstep, voffB);
            PG8_WAIT_V(6); PG8_BAR; PG8_MMA(1, 1, At, B1); PG8_BAR;
            }
        }
        if constexpr (ALIGN_EPI) { if (wr == 0) PG8_BAR; }
        if constexpr (!Epi::AFTER_DRAIN) { E(acc, cur, wr, wc, fr, fq); S.done(cur); }
        if (!has_next) break;
#pragma unroll
        for (int a = 0; a < 2; ++a)
#pragma unroll
            for (int b = 0; b < 2; ++b)
#pragma unroll
                for (int m = 0; m < 4; ++m)
#pragma unroll
                    for (int n = 0; n < 2; ++n) acc[a][b][m][n] = (f32x4){0.f, 0.f, 0.f, 0.f};
        cur = nxt; cA = nA; cB = nB; ++ui;
        if constexpr (ALIGN_EPI) { if (wr == 1) PG8_BAR; }
    }
    PG8_WAIT_V(0);
    if constexpr (!ALIGN_EPI) { if (wr == 0) PG8_BAR; }
    PG8_BAR;
    if constexpr (Epi::AFTER_DRAIN) { E.fused(acc, cur, wr, wc, fr, fq, lds, wid, lane); S.done(cur); }
#undef PG8_SA
#undef PG8_SB
#undef PG8_STAGE
#undef PG8_LDA
#undef PG8_LDB
#undef PG8_MMA
#undef PG8_WAIT_V
#undef PG8_WAIT_L
#undef PG8_BAR
#undef PG8_SCHED
}
}
struct Params {
    const float* in[45];
    float* out; unsigned char* ws;
    int ph_lo, ph_hi, coop, pad;
    unsigned char bucket[128];
};
enum InIdx { I_XP = 0, I_XS, I_CKC, I_CKS, I_SKW, I_SRE, I_SIM, I_PT, I_PP, I_PS, I_RELB, I_G1, I_W1G, I_W1U, I_W1D, I_GMIX, I_WIN, I_CPK, I_CW1K, I_CB1K, I_CW2K, I_CPV, I_CW1V, I_CB1V, I_CW2V,
             I_LRE, I_LIM, I_LDT, I_BRE, I_BIM, I_CRE, I_CIM, I_SD, I_WGLU, I_WBA, I_WBS, I_WOUT, I_G2, I_W2G, I_W2U, I_W2D, I_GPLE, I_WPG, I_WPP, I_GFIN };

struct Frame { LAS unsigned char* lds; int tid, lane, wave, G, vcu; };
__device__ __forceinline__ Frame launder(Frame F) { asm volatile("" : "+v"(F.tid)); F.lane = F.tid & 63; F.wave = __builtin_amdgcn_readfirstlane(F.tid >> 6); int g = F.G, v = F.vcu; asm volatile("" : "+s"(g), "+s"(v)); F.G = g; F.vcu = v; return F; }
__device__ __forceinline__ float wave_sum(float v) {
#pragma unroll
    for (int o = 1; o < 64; o <<= 1) v += __shfl_xor(v, o);
    return v;
}

__device__ __forceinline__ void transpose_item(const float* W, int N, bf16* WT, int KT, int k0, int drow0, int scol0, int nvalid, const float* gk, LAS float* scr, int lane) {
    { const int c4 = (lane & 7) * 4; f32x4 v[8];
#pragma unroll
      for (int i = 0; i < 8; ++i) { const int kk = 8 * i + (lane >> 3); v[i] = (f32x4){0.f, 0.f, 0.f, 0.f};
          if (c4 < nvalid) { v[i] = *(const f32x4*)(W + (size_t)(k0 + kk) * N + scol0 + c4); if (gk) v[i] = v[i] * gk[k0 + kk]; } }
#pragma unroll
      for (int i = 0; i < 8; ++i) { const int kk = 8 * i + (lane >> 3); LAS float* d = scr + kk * 33 + c4; d[0] = v[i][0]; d[1] = v[i][1]; d[2] = v[i][2]; d[3] = v[i][3]; } }
    LDS_WAIT();
    const int c8 = lane & 7;
#pragma unroll
    for (int j = 0; j < 4; ++j) { const int n = (lane >> 3) + 8 * j; const LAS float* s = scr + (8 * c8) * 33 + n;
        u32x4 o; o.x = pk2(s[0 * 33], s[1 * 33]); o.y = pk2(s[2 * 33], s[3 * 33]); o.z = pk2(s[4 * 33], s[5 * 33]); o.w = pk2(s[6 * 33], s[7 * 33]);
        *(u32x4*)(WT + (size_t)(drow0 + n) * KT + k0 + 8 * c8) = o; }
    LDS_WAIT();
}
__device__ __forceinline__ void row256_to_bf16(const float* src, bf16* dst, int lane) {
    const f32x4 v = *(const f32x4*)(src + 4 * lane); u32x2 w; w.x = pk2(v[0], v[1]); w.y = pk2(v[2], v[3]); *(u32x2*)(dst + 4 * lane) = w;
}

__device__ __forceinline__ void ssm_tables_item(const Params& P, LAS float* L, int item, int tid) {
    const int g = item >> 3, q = item & 7;
    LAS float* apw = L;
    LAS float* bbl = L + 33 * 128;
    LAS float* ccl = bbl + 2048;
    LAS float* krn = ccl + 2048;
    unsigned char* ws = P.ws;
    if (tid < 64) { const int p = tid;
        const float dt = expf(P.in[I_LDT][g]), lr = P.in[I_LRE][g * 64 + p], li = P.in[I_LIM][g * 64 + p];
        const float mag = expf(lr * dt), ang = li * dt, ar = mag * cosf(ang), ai = mag * sinf(ang);
        const float den = lr * lr + li * li, fr = ((ar - 1.0f) * lr + ai * li) / den, fi = (ai * lr - (ar - 1.0f) * li) / den;
        float pr = 1.f, pi = 0.f;
        for (int k = 0; k <= 32; ++k) { apw[(k * 64 + p) * 2] = pr; apw[(k * 64 + p) * 2 + 1] = pi; const float nr = pr * ar - pi * ai, ni = pr * ai + pi * ar; pr = nr; pi = ni; }
        for (int c = 0; c < 16; ++c) { const float br = P.in[I_BRE][(g * 64 + p) * 16 + c], bi = P.in[I_BIM][(g * 64 + p) * 16 + c];
            const float xr = fr * br - fi * bi, xi = fr * bi + fi * br; bbl[(p * 16 + c) * 2] = xr; bbl[(p * 16 + c) * 2 + 1] = xi;
            if (q == 0) { ((float*)(ws + WS_BBT))[((g * 64 + p) * 16 + c) * 2] = xr; ((float*)(ws + WS_BBT))[((g * 64 + p) * 16 + c) * 2 + 1] = xi; } }
        if (q == 0) { ((float*)(ws + WS_ABT))[(g * 64 + p) * 2] = ar; ((float*)(ws + WS_ABT))[(g * 64 + p) * 2 + 1] = ai; }
    }
    for (int e = tid; e < 1024; e += NTHREADS) { const int c = e >> 6, p = e & 63; ccl[e * 2] = P.in[I_CRE][(g * 16 + c) * 64 + p]; ccl[e * 2 + 1] = P.in[I_CIM][(g * 16 + c) * 64 + p]; }
    __syncthreads();
    if (q == 0 && tid < 64) { ((float*)(ws + WS_ABL))[(g * 64 + tid) * 2] = apw[(32 * 64 + tid) * 2]; ((float*)(ws + WS_ABL))[(g * 64 + tid) * 2 + 1] = apw[(32 * 64 + tid) * 2 + 1]; }
    for (int o = tid; o < 1024; o += NTHREADS) { const int k = o >> 8, c = (o >> 4) & 15, c2 = o & 15, lag = q + 8 * k; float s = 0.f;
        for (int p = 0; p < 64; ++p) { const float ar = apw[(lag * 64 + p) * 2], ai = apw[(lag * 64 + p) * 2 + 1], br = bbl[(p * 16 + c2) * 2], bi = bbl[(p * 16 + c2) * 2 + 1];
            const float tr = ar * br - ai * bi, ti = ar * bi + ai * br; s += ccl[(c * 64 + p) * 2] * tr - ccl[(c * 64 + p) * 2 + 1] * ti; }
        krn[o] = s; }
    __syncthreads();
    bf16* TZ = (bf16*)(ws + WS_TZ) + (size_t)g * 512 * 512;
    for (int e = tid; e < 2048; e += NTHREADS) { const int k = e >> 9, j = (e >> 4) & 31, c = e & 15, lag = q + 8 * k;
        if (j >= lag) { const int i = j - lag; const LAS float* kp = krn + k * 256 + c * 16; u32x4 w0, w1;
            w0.x = pk2(kp[0], kp[1]); w0.y = pk2(kp[2], kp[3]); w0.z = pk2(kp[4], kp[5]); w0.w = pk2(kp[6], kp[7]); w1.x = pk2(kp[8], kp[9]); w1.y = pk2(kp[10], kp[11]); w1.z = pk2(kp[12], kp[13]); w1.w = pk2(kp[14], kp[15]);
            bf16* d = TZ + (size_t)(j * 16 + c) * 512 + i * 16; *(u32x4*)d = w0; *(u32x4*)(d + 8) = w1; } }
    { const int rr = tid >> 3, seg = tid & 7, j = q + 8 * (rr >> 4), c = rr & 15; bf16* d = TZ + (size_t)(j * 16 + c) * 512;
#pragma unroll
      for (int r4 = 0; r4 < 4; ++r4) { const int col = 64 * seg + 16 * r4; if (col >= (j + 1) * 16) { *(u32x4*)(d + col) = (u32x4){0u, 0u, 0u, 0u}; *(u32x4*)(d + col + 8) = (u32x4){0u, 0u, 0u, 0u}; } } }
    { const int n = 16 * q + (tid >> 5), i = tid & 31, p = n & 63, im = n >> 6; const float ar = apw[((31 - i) * 64 + p) * 2], ai = apw[((31 - i) * 64 + p) * 2 + 1]; float v[16];
#pragma unroll
      for (int c = 0; c < 16; ++c) { const float br = bbl[(p * 16 + c) * 2], bi = bbl[(p * 16 + c) * 2 + 1]; v[c] = im ? (ar * bi + ai * br) : (ar * br - ai * bi); }
      bf16* d = (bf16*)(ws + WS_PT) + ((size_t)g * 128 + n) * 512 + i * 16; u32x4 w0, w1;
      w0.x = pk2(v[0], v[1]); w0.y = pk2(v[2], v[3]); w0.z = pk2(v[4], v[5]); w0.w = pk2(v[6], v[7]); w1.x = pk2(v[8], v[9]); w1.y = pk2(v[10], v[11]); w1.z = pk2(v[12], v[13]); w1.w = pk2(v[14], v[15]);
      *(u32x4*)d = w0; *(u32x4*)(d + 8) = w1; }
    { const int row = 64 * q + (tid >> 3), n0 = (tid & 7) * 16, j = row >> 4, c = row & 15; float v[16];
#pragma unroll
      for (int e = 0; e < 16; ++e) { const int n = n0 + e, p = n & 63; const float ar = apw[((j + 1) * 64 + p) * 2], ai = apw[((j + 1) * 64 + p) * 2 + 1], cr = ccl[(c * 64 + p) * 2], ci = ccl[(c * 64 + p) * 2 + 1];
          v[e] = (n0 < 64) ? (cr * ar - ci * ai) : -(cr * ai + ci * ar); }
      bf16* d = (bf16*)(ws + WS_WC) + ((size_t)g * 512 + row) * 128 + n0; u32x4 w0, w1;
      w0.x = pk2(v[0], v[1]); w0.y = pk2(v[2], v[3]); w0.z = pk2(v[4], v[5]); w0.w = pk2(v[6], v[7]); w1.x = pk2(v[8], v[9]); w1.y = pk2(v[10], v[11]); w1.z = pk2(v[12], v[13]); w1.w = pk2(v[14], v[15]);
      *(u32x4*)d = w0; *(u32x4*)(d + 8) = w1; }
    __syncthreads();
}

__device__ __forceinline__ void transpose_jobs(const Params& P, unsigned jobmask, int gw, int NGW, LAS float* scr, int lane);
__device__ __forceinline__ void background_copy(const Params& P, int gw, int NGW, int lane, LAS float* scr) {
    unsigned char* ws = P.ws;
    transpose_jobs(P, 0x07F8, gw, NGW, scr, lane);
    { bf16* PB = (bf16*)(ws + WS_PB);
      for (int m0 = gw * 4; m0 < MR; m0 += NGW * 4) { f32x4 v[4];
#pragma unroll
          for (int i = 0; i < 4; ++i) { const int m = m0 + i; v[i] = *(const f32x4*)((m < NP ? P.in[I_PP] + (size_t)m * PLE : P.in[I_PS] + (size_t)(m - NP) * PLE) + 4 * lane); }
#pragma unroll
          for (int i = 0; i < 4; ++i) { u32x2 w; w.x = pk2(v[i][0], v[i][1]); w.y = pk2(v[i][2], v[i][3]); *(u32x2*)(PB + (size_t)(m0 + i) * PLE + 4 * lane) = w; } } }
    { bf16* CCB = (bf16*)(ws + WS_CCB); const int* pt = (const int*)P.in[I_PT];
      for (int r0 = gw * 8; r0 < DB * PAST; r0 += NGW * 8) { const int b = r0 >> 11, pos0 = r0 & 2047; const int page = pt[b * 16 + (pos0 >> 7)];
          const float* src = P.in[I_CKC] + ((size_t)page * 128 + (pos0 & 127)) * 256 + 4 * lane; f32x4 v[8];
#pragma unroll
          for (int i = 0; i < 8; ++i) v[i] = __builtin_nontemporal_load((const f32x4*)(src + (size_t)i * 256));
#pragma unroll
          for (int i = 0; i < 8; ++i) { u32x2 w; w.x = pk2(v[i][0], v[i][1]); w.y = pk2(v[i][2], v[i][3]); *(u32x2*)(CCB + (size_t)(r0 + i) * 256 + 4 * lane) = w; } } }
    { float* o = P.out + O_KVWS;
      for (int r0 = gw * 4; r0 < DB * 508; r0 += NGW * 4) { const int b = r0 / 508, i0 = r0 % 508; f32x4 v[4];
#pragma unroll
          for (int i = 0; i < 4; ++i) v[i] = __builtin_nontemporal_load((const f32x4*)(P.in[I_SKW] + ((size_t)b * 512 + i0 + i + 4) * 256 + 4 * lane));
#pragma unroll
          for (int i = 0; i < 4; ++i) __builtin_nontemporal_store(v[i], (f32x4*)(o + ((size_t)b * 512 + i0 + i) * 256 + 4 * lane)); } }
}
struct TJob { int src; int K, N, ndest, kind, gk; size_t wt; int ktot; };
__constant__ const TJob g_jobs[13] = {
        {I_W1G, DM, FF, 2 * FF, 1, I_G1, WS_WGU1, DM}, {I_W1D, FF, DM, DM, 0, -1, WS_WD1, FF}, {I_WIN, DM, 3864, NIN, 2, I_GMIX, WS_WIN, DM}, {I_WGLU, 512, 512, 512, 0, -1, WS_WGLU, 512},
        {I_WBA, 512, DM, DM, 0, -1, WS_WBA, 1024}, {I_WBS, 512, DM, DM, 0, -1, WS_WBA + 1024, 1024}, {I_WOUT, DM, DM, DM, 0, -1, WS_WOUT, DM}, {I_W2G, DM, FF, 2 * FF, 1, I_G2, WS_WGU2, DM},
        {I_W2D, FF, DM, DM, 0, -1, WS_WD2, FF}, {I_WPG, DM, DM, DM, 0, I_GPLE, WS_WPG, DM}, {I_WPP, PLE, DM, DM, 0, -1, WS_WPP, PLE}, {I_CW1K, 1024, 128, 512, 3, -1, WS_WC1, 1024}, {I_CW2K, 128, 64, 128, 4, -1, WS_WC2, 128} };
__device__ __forceinline__ void transpose_jobs(const Params& P, unsigned jobmask, int gw, int NGW, LAS float* scr, int lane) {
    unsigned char* ws = P.ws;
    int base = 0;
#pragma unroll 1
    for (int jb = 0; jb < 13; ++jb) { if (!((jobmask >> jb) & 1u)) continue; const TJob J = g_jobs[jb]; const int nkb = J.K / 64, nnb = J.ndest / 32, nit = nkb * nnb;
        for (int it = gw - base % NGW; it < nit; it += NGW) { if (it < 0) continue;
            const int kb = it / nnb, nb = it % nnb, k0 = 64 * kb, d0 = 32 * nb; const float* W = P.in[J.src]; int scol0 = d0, nvalid = 32, N = J.N; bf16* WT = (bf16*)(ws + J.wt);
            if (J.kind == 1) { const int tile = d0 >> 8, within = d0 & 255; if (within >= 128) W = P.in[J.src + 1]; scol0 = tile * 128 + (within & 127); }
            else if (J.kind == 2) { if (d0 < 1280) scol0 = d0; else if (d0 < 1792) scol0 = d0 + 24; else if (d0 < 3840) { const int tile = (d0 - 1792) >> 8, within = (d0 - 1792) & 255; scol0 = 1816 + (within >= 128 ? 1024 : 0) + tile * 128 + (within & 127); } else if (d0 == 3840) { scol0 = 1280; nvalid = 24; } else nvalid = 0; }
            else if (J.kind == 3) { const int type = d0 >> 8, within = d0 & 255; W = P.in[type ? I_CW1V : I_CW1K]; if (within >= 128) W += (size_t)1024 * 128; scol0 = within & 127; WT += 0; }
            else if (J.kind == 4) { const int type = d0 >> 6; W = P.in[type ? I_CW2V : I_CW2K]; scol0 = d0 & 63; }
            transpose_item(W, N, WT, J.ktot, k0, d0, scol0, nvalid, J.gk >= 0 ? P.in[J.gk] : nullptr, scr, lane); }
        base += nit; }
}
__device__ __forceinline__ void prologue(const Params& P, const Frame& F) {
    unsigned char* ws = P.ws;
    LAS float* scr = (LAS float*)(F.lds + F.wave * 16384);
    const int gw = F.vcu * NWAVES + F.wave, NGW = F.G * NWAVES, lane = F.lane;
    transpose_jobs(P, 0x1807, gw, NGW, scr, lane);
    { bf16* XB = (bf16*)(ws + WS_XB); float* ssq0 = (float*)(ws + WS_SSQ0);
      for (int m = gw; m < MR; m += NGW) { const float* xr = m < NP ? P.in[I_XP] + (size_t)m * DM : P.in[I_XS] + (size_t)(m - NP) * DM; float s = 0.f; f32x4 v[4];
#pragma unroll
          for (int j = 0; j < 4; ++j) v[j] = *(const f32x4*)(xr + 256 * j + 4 * lane);
#pragma unroll
          for (int j = 0; j < 4; ++j) { s += (v[j][0] * v[j][0] + v[j][1] * v[j][1]) + (v[j][2] * v[j][2] + v[j][3] * v[j][3]);
              u32x2 w; w.x = pk2(v[j][0], v[j][1]); w.y = pk2(v[j][2], v[j][3]); *(u32x2*)(XB + (size_t)m * DM + 256 * j + 4 * lane) = w; }
          s = wave_sum(s); if (lane == 0) ssq0[m] = s; } }
    { float* cc = (float*)(ws + WS_CCON);
      for (int it = gw; it < 128; it += NGW) { const int type = it >> 6, nh = (it >> 5) & 1, kc = it & 31, n = nh * 64 + lane; const float* pos = P.in[type ? I_CPV : I_CPK] + kc * 64; const float* w1 = P.in[type ? I_CW1V : I_CW1K] + (size_t)kc * 64 * 128 + n;
          float s = kc == 0 ? P.in[type ? I_CB1V : I_CB1K][n] : 0.f;
#pragma unroll 16
          for (int k = 0; k < 64; ++k) s += pos[k] * w1[(size_t)k * 128];
          atomicAdd(cc + type * 128 + n, s); } }
    if (blockIdx.x == 0) { float* bt = (float*)(ws + WS_BIAS);
      for (int e = F.tid; e < 8 * 136; e += NTHREADS) { const int h = e / 136, n = e % 136; const int bk = n < 128 ? (int)P.bucket[n] : 31; bt[e] = P.in[I_RELB][bk * 8 + h] * LOG2E; } }
}
namespace att {
constexpr int SLOTB = 8192;
constexpr int L_K = 0, L_V = 2 * SLOTB, L_WS = 4 * SLOTB, L_IMP = L_WS + 2048, L_SEL = L_IMP + 4 * 64 * 33 * 4, L_UNI = L_SEL + 512, L_BT = L_UNI + 16, L_RES = L_BT + 8 * 136 * 4, L_END = L_RES + 8 * 8192;
typedef short v4i16_t __attribute__((ext_vector_type(4)));
__device__ __forceinline__ int crow(int r, int hi) { return (r & 3) + 8 * (r >> 2) + 4 * hi; }
__device__ __forceinline__ void swap_halves(float v, float& r0, float& r1) { float a = v, b = v;
    asm volatile("s_nop 1\n\tv_permlane32_swap_b32 %0, %1\n\ts_nop 1" : "+v"(a), "+v"(b)); r0 = a; r1 = b; }
__device__ __forceinline__ float other_half(float v, int hi) { float r0, r1; swap_halves(v, r0, r1); return hi ? r0 : r1; }
__device__ __forceinline__ float max_halves(float v) { float r0, r1; swap_halves(v, r0, r1); return fmaxf(r0, r1); }
__device__ __forceinline__ float sum_halves(float v) { float r0, r1; swap_halves(v, r0, r1); return r0 + r1; }

__device__ __forceinline__ void qkt(f32x16& p0, f32x16& p1, const LAS char* Ks, const bf16x8* qr, int r32, int hi, float cinit = 0.f) {
    const LAS char* kb = Ks + hi * 1024 + r32 * 16;
#pragma unroll
    for (int r = 0; r < 16; ++r) { p0[r] = cinit; p1[r] = cinit; }
#pragma unroll
    for (int d0 = 0; d0 < 4; ++d0) { const bf16x8 b0 = *(const LAS bf16x8*)(kb + d0 * 2048), b1 = *(const LAS bf16x8*)(kb + d0 * 2048 + 512);
        p0 = __builtin_amdgcn_mfma_f32_32x32x16_bf16(b0, qr[d0], p0, 0, 0, 0); p1 = __builtin_amdgcn_mfma_f32_32x32x16_bf16(b1, qr[d0], p1, 0, 0, 0); }
}
__device__ __forceinline__ s16x4 vtr(const LAS char* p) { return __builtin_bit_cast(s16x4, __builtin_amdgcn_ds_read_tr16_b64_v4i16((LAS v4i16_t*)p)); }
__device__ __forceinline__ void pv(f32x16* o, const LAS char* Vs, const bf16x8* pa, int lane, int hi) {
    const LAS char* vp = Vs + ((lane >> 4) & 1) * 32 + (lane & 3) * 8 + (4 * hi + ((lane & 15) >> 2)) * 64;
#pragma unroll
    for (int d0 = 0; d0 < 2; ++d0)
#pragma unroll
        for (int ks = 0; ks < 4; ++ks) { const s16x4 lo = vtr(vp + d0 * 4096 + ks * 1024), hh = vtr(vp + d0 * 4096 + ks * 1024 + 512);
            const bf16x8 vf = (bf16x8){lo[0], lo[1], lo[2], lo[3], hh[0], hh[1], hh[2], hh[3]};
            o[d0] = __builtin_amdgcn_mfma_f32_32x32x16_bf16(pa[ks], vf, o[d0], 0, 0, 0); }
}
__device__ __forceinline__ void pack_p(bf16x8* pa, const f32x16& p0, const f32x16& p1) {
#pragma unroll
    for (int k = 0; k < 2; ++k) { u32x4 w, x;
        w.x = pk2(p0[8 * k], p0[8 * k + 1]); w.y = pk2(p0[8 * k + 2], p0[8 * k + 3]); w.z = pk2(p0[8 * k + 4], p0[8 * k + 5]); w.w = pk2(p0[8 * k + 6], p0[8 * k + 7]);
        x.x = pk2(p1[8 * k], p1[8 * k + 1]); x.y = pk2(p1[8 * k + 2], p1[8 * k + 3]); x.z = pk2(p1[8 * k + 4], p1[8 * k + 5]); x.w = pk2(p1[8 * k + 6], p1[8 * k + 7]);
        pa[k] = __builtin_bit_cast(bf16x8, w); pa[2 + k] = __builtin_bit_cast(bf16x8, x); }
}
template <bool NEAR> __device__ __forceinline__ void mask_bias(f32x16& p0, f32x16& p1, int tq, int kbase, int kstride, int maxdist, bool rowok, const LAS float* btl, float bfar, int hi) {
#pragma unroll
    for (int r = 0; r < 16; ++r) { const int kl = crow(r, hi); const int d0 = tq - (kbase + kl * kstride), d1 = d0 - 32 * kstride;
        const bool v0 = rowok && d0 >= 0 && d0 <= maxdist, v1 = rowok && d1 >= 0 && d1 <= maxdist;
        float b0 = bfar, b1 = bfar;
        if (NEAR) { b0 = btl[min(max(d0, 0), 128)]; b1 = btl[min(max(d1, 0), 128)]; }
        p0[r] = v0 ? p0[r] + b0 : -INFINITY; p1[r] = v1 ? p1[r] + b1 : -INFINITY; }
}
__device__ __forceinline__ float rowmax32(const f32x16& p0, const f32x16& p1) {
    float a = fmaxf(p0[0], p1[0]);
#pragma unroll
    for (int r = 1; r < 16; ++r) a = fmaxf(a, fmaxf(p0[r], p1[r]));
    return a;
}
__device__ __forceinline__ float max3f(float a, float b, float c) { float r; asm("v_max3_f32 %0, %1, %2, %3" : "=v"(r) : "v"(a), "v"(b), "v"(c)); return r; }
__device__ __forceinline__ void tile_step(const LAS char* Ks, const LAS char* Vs, const bf16x8* qr, f32x16* o, float& ref, float& l, LAS float* wsf,
                                          int tq, int kbase, int maxdist, bool rowok, bool near, bool allin, const LAS float* btl, float bfar, int lane) {
    const int r32 = lane & 31, hi = lane >> 5;
    f32x16 p0, p1; qkt(p0, p1, Ks, qr, r32, hi);
    if (!allin) mask_bias<true>(p0, p1, tq, kbase, 1, maxdist, rowok, btl, bfar, hi);
    if (__any(ref != 0.f)) {
#pragma unroll
        for (int r = 0; r < 16; ++r) { p0[r] -= ref; p1[r] -= ref; } }
    float a = max3f(p0[0], p0[1], p1[0]), b = max3f(p0[2], p0[3], p1[1]); a = max3f(a, p1[2], p1[3]);
#pragma unroll
    for (int r = 4; r < 16; r += 4) { a = max3f(a, p0[r], p0[r + 1]); b = max3f(b, p0[r + 2], p0[r + 3]); a = max3f(a, p1[r], p1[r + 1]); b = max3f(b, p1[r + 2], p1[r + 3]); }
    float rm = max_halves(fmaxf(a, b));
    if (allin && !rowok) rm = -INFINITY;
    if (__any(rm > 8.0f)) { const float dl = rm > 8.0f ? rm : 0.f; ref += dl; const float f = fast_exp2(-dl); l *= f;
#pragma unroll
        for (int r = 0; r < 16; ++r) { p0[r] -= dl; p1[r] -= dl; const float fr = __shfl(f, crow(r, hi)); o[0][r] *= fr; o[1][r] *= fr; } }
    float s = 0.f;
#pragma unroll
    for (int r = 0; r < 16; ++r) { p0[r] = fast_exp2(p0[r]); p1[r] = fast_exp2(p1[r]); s += p0[r] + p1[r]; }
    if (allin && !__all(rowok)) { const float okf = rowok ? 1.f : 0.f; s *= okf;
#pragma unroll
        for (int r = 0; r < 16; ++r) { p0[r] *= okf; p1[r] *= okf; } }
    l += s;
    bf16x8 pa[4]; pack_p(pa, p0, p1);
    pv(o, Vs, pa, lane, hi);
}
template <bool FIRST> __device__ __forceinline__ void add_scaled(LAS float* resl, const f32x16* o, float fac, LAS float* wsf, int lane, int r32, int hi) {
#pragma unroll
    for (int r = 0; r < 16; ++r) { const float fr = __shfl(fac, crow(r, hi));
        if (FIRST) { resl[r * 64 + lane] = o[0][r] * fr; resl[(16 + r) * 64 + lane] = o[1][r] * fr; }
        else { resl[r * 64 + lane] += o[0][r] * fr; resl[(16 + r) * 64 + lane] += o[1][r] * fr; } }
    LDS_WAIT();
}
__device__ __forceinline__ u32x4 load8(const void* p, int kind) {
    if (kind == 1) return *(const u32x4*)p;
    if (kind == 2) { const f32x4 a = ((const f32x4*)p)[0], b = ((const f32x4*)p)[1]; u32x4 w; w.x = pk2(a[0], a[1]); w.y = pk2(a[2], a[3]); w.z = pk2(b[0], b[1]); w.w = pk2(b[2], b[3]); return w; }
    return (u32x4){0u, 0u, 0u, 0u};
}

template <bool SAMPLE> __device__ __forceinline__ void attn_unit(const Params& P, const Frame& F, int b, int hkv, int qt) {
    unsigned char* ws = P.ws;
    LAS char* lds = (LAS char*)F.lds;
    const int tid = F.tid, lane = F.lane, wave = F.wave, r32 = lane & 31, hi = lane >> 5, g = wave & 3, half = wave >> 2, head = hkv * 4 + g;
    const bf16* Qb = (const bf16*)(ws + WS_Q); const bf16* KVS = (const bf16*)(ws + WS_KVS); const bf16* KVW = (const bf16*)(ws + WS_KVW);
    const float* NG = (const float*)(ws + WS_NG);
    int tok, tq, qrow; bool tvalid;
    if (SAMPLE) { tok = r32 < 3 ? r32 : 3; tvalid = (r32 < 4) && (half == 0); tq = PAST + tok; qrow = NP + b * DS + tok; }
    else { tok = 32 * half + r32; tvalid = true; tq = 64 * qt + tok; qrow = b * SEQ + tq; }
    const int ba = SAMPLE ? b : DB + b, bt = SAMPLE ? 32 : qt, tqmin = SAMPLE ? PAST : 64 * qt + 32 * half, tqmax = SAMPLE ? PAST + DS - 1 : tqmin + 31;
    bf16x8 qr[4];
#pragma unroll
    for (int d0 = 0; d0 < 4; ++d0) qr[d0] = *(const bf16x8*)(Qb + (size_t)qrow * 512 + head * 64 + hi * 8 + d0 * 16);
    float gate_c = NG[(size_t)qrow * 24 + head * 3 + 0], gate_s = NG[(size_t)qrow * 24 + head * 3 + 1], gate_w = NG[(size_t)qrow * 24 + head * 3 + 2];
    LAS float* wsf = (LAS float*)(lds + L_WS) + wave * 64;
    const LAS float* btl = (const LAS float*)(lds + L_BT) + head * 136;
    const float bfar = btl[128];
    LAS float* resl = (LAS float*)(lds + L_RES) + wave * 2048;
    const int kkey = tid >> 3, kchunk = tid & 7;
    const int vkey = kkey, vd = kchunk * 8;
    const int kdst = kchunk * 1024 + kkey * 16, vdst = ((kchunk >> 2) * 4 + (kkey >> 4)) * 1024 + (kkey & 15) * 64 + (kchunk & 3) * 16;

    __syncthreads();
    { const bf16* KCb = (const bf16*)(ws + WS_KC) + (size_t)(ba * 2 + hkv) * 128 * 64; const bf16* VCb = (const bf16*)(ws + WS_VC) + (size_t)(ba * 2 + hkv) * 128 * 64;
#pragma unroll
      for (int jt = 0; jt < 2; ++jt) { *(LAS u32x4*)(lds + L_K + jt * SLOTB + kdst) = *(const u32x4*)(KCb + (size_t)(64 * jt + kkey) * 64 + kchunk * 8);
          *(LAS u32x4*)(lds + L_V + jt * SLOTB + vdst) = *(const u32x4*)(VCb + (size_t)(64 * jt + vkey) * 64 + vd); } }
    __syncthreads();
    {
        float m = -INFINITY, l = 0.f;
#pragma unroll 1
        for (int jt = 0; jt < 2; ++jt) { f32x16 a0, a1; qkt(a0, a1, lds + L_K + jt * SLOTB, qr, r32, hi);
            mask_bias<true>(a0, a1, tq, 31 + 1024 * jt, 16, 1 << 30, tvalid, btl, bfar, hi);
            const float rm = max_halves(rowmax32(a0, a1)), mnew = fmaxf(m, rm), ms = (mnew == -INFINITY) ? 0.f : mnew; float s = 0.f;
#pragma unroll
            for (int r = 0; r < 16; ++r) s += fast_exp2(a0[r] - ms) + fast_exp2(a1[r] - ms);
            l = l * fast_exp2(m - ms) + s; m = mnew; }
        const float L = sum_halves(l), inv = L > 0.f ? 1.0f / L : 0.f, ms = (m == -INFINITY) ? 0.f : m;
        LAS float* impw = (LAS float*)(lds + L_IMP) + (g * 64 + tok) * 33;
        float eprev = 0.f;
        f32x16 o[2]; o[0] = (f32x16){}; o[1] = (f32x16){};
#pragma unroll 1
        for (int jt = 0; jt < 2; ++jt) { f32x16 a0, a1; qkt(a0, a1, lds + L_K + jt * SLOTB, qr, r32, hi);
            mask_bias<true>(a0, a1, tq, 31 + 1024 * jt, 16, 1 << 30, tvalid, btl, bfar, hi);
#pragma unroll
            for (int r = 0; r < 16; ++r) { a0[r] = fast_exp2(a0[r] - ms) * inv; a1[r] = fast_exp2(a1[r] - ms) * inv; }
#pragma unroll
            for (int n = 0; n < 8; ++n) { const int a = n & 3, c = n >> 2;
                const f32x16& pp = c ? a1 : a0;
                const float G = (pp[4 * a] + pp[4 * a + 1]) + (pp[4 * a + 2] + pp[4 * a + 3]), E = pp[4 * a + 3];
                const float eo = other_half(E, hi);
                const float imp = G + (hi ? eo : eprev);
                eprev = eo;
                if (tvalid) impw[2 * (n + 8 * jt) + hi] = imp; }
            bf16x8 pa[4]; pack_p(pa, a0, a1); pv(o, lds + L_V + jt * SLOTB, pa, lane, hi); }
        add_scaled<true>(resl, o, gate_c, wsf, lane, r32, hi);
    }
    __syncthreads();
    if (tid < 64) {
        unsigned long long mask = 0ull;
        if (!SAMPLE || tid < 4) {
            LAS float* sc = (LAS float*)(lds + L_IMP) + tid * 33;
            for (int s = 0; s < 32; ++s) sc[s] = (sc[s] + sc[64 * 33 + s]) + (sc[2 * 64 * 33 + s] + sc[3 * 64 * 33 + s]);
            mask = 1ull | (1ull << bt); if (bt >= 1) mask |= 1ull << (bt - 1);
            const int picks = 8 - __popcll(mask);
            for (int it = 0; it < picks; ++it) { int best = -1; float bv = -1.0f;
                for (int s = 1; s <= bt - 2; ++s) { const float v = sc[s]; if (!((mask >> s) & 1ull) && v > bv) { bv = v; best = s; } }
                if (best >= 0) mask |= 1ull << best; }
        }
        ((LAS unsigned*)(lds + L_SEL))[2 * tid] = (unsigned)mask; ((LAS unsigned*)(lds + L_SEL))[2 * tid + 1] = (unsigned)(mask >> 32);
        unsigned ulo = (unsigned)mask, uhi = (unsigned)(mask >> 32);
#pragma unroll
        for (int o = 1; o < 64; o <<= 1) { ulo |= __shfl_xor(ulo, o); uhi |= __shfl_xor(uhi, o); }
        if (tid == 0) { ((LAS unsigned*)(lds + L_UNI))[0] = ulo; ((LAS unsigned*)(lds + L_UNI))[1] = uhi; }
    }
    __syncthreads();
    const unsigned long long mysel = (unsigned long long)((LAS unsigned*)(lds + L_SEL))[2 * tok] | ((unsigned long long)((LAS unsigned*)(lds + L_SEL))[2 * tok + 1] << 32);
    unsigned long long U = (unsigned long long)((LAS unsigned*)(lds + L_UNI))[0] | ((unsigned long long)((LAS unsigned*)(lds + L_UNI))[1] << 32);

    const int* ptab = (const int*)P.in[I_PT] + b * 16;
#define ATT_LOAD(br, j, rk, rv) do { \
        const void* pk_ = nullptr; const void* pv_ = nullptr; int kk_ = 0, kv_ = 0; \
        if (!SAMPLE) { const bf16* src_ = (br) == 1 ? KVS : KVW; \
            pk_ = src_ + (size_t)(b * SEQ + 64 * (j) + kkey) * 256 + hkv * 64 + kchunk * 8; pv_ = src_ + (size_t)(b * SEQ + 64 * (j) + vkey) * 256 + 128 + hkv * 64 + vd; kk_ = 1; kv_ = 1; } \
        else if ((br) == 1) { const int pk0 = 64 * (j) + kkey, pv0 = 64 * (j) + vkey; \
            if (pk0 < PAST) { pk_ = P.in[I_CKS] + ((size_t)ptab[pk0 >> 7] * 128 + (pk0 & 127)) * 256 + hkv * 64 + kchunk * 8; kk_ = 2; } \
            else if (pk0 < PAST + DS) { pk_ = KVS + (size_t)(NP + b * DS + pk0 - PAST) * 256 + hkv * 64 + kchunk * 8; kk_ = 1; } \
            if (pv0 < PAST) { pv_ = P.in[I_CKS] + ((size_t)ptab[pv0 >> 7] * 128 + (pv0 & 127)) * 256 + 128 + hkv * 64 + vd; kv_ = 2; } \
            else if (pv0 < PAST + DS) { pv_ = KVS + (size_t)(NP + b * DS + pv0 - PAST) * 256 + 128 + hkv * 64 + vd; kv_ = 1; } } \
        else { const int wk0 = 64 * (j) + kkey, wv0 = 64 * (j) + vkey; \
            if (wk0 < 512) { pk_ = P.in[I_SKW] + ((size_t)b * 512 + wk0) * 256 + hkv * 64 + kchunk * 8; kk_ = 2; } \
            else if (wk0 < 512 + DS) { pk_ = KVW + (size_t)(NP + b * DS + wk0 - 512) * 256 + hkv * 64 + kchunk * 8; kk_ = 1; } \
            if (wv0 < 512) { pv_ = P.in[I_SKW] + ((size_t)b * 512 + wv0) * 256 + 128 + hkv * 64 + vd; kv_ = 2; } \
            else if (wv0 < 512 + DS) { pv_ = KVW + (size_t)(NP + b * DS + wv0 - 512) * 256 + 128 + hkv * 64 + vd; kv_ = 1; } } \
        rk = load8(pk_, kk_); rv = load8(pv_, kv_); } while (0)

    {
        f32x16 o[2]; o[0] = (f32x16){}; o[1] = (f32x16){}; float m = 0.f, l = 0.f;
        u32x4 rk, rv; int idx = 0;
        { const int j0 = __builtin_ctzll(U); ATT_LOAD(1, j0, rk, rv); }
        while (U) { const int j = __builtin_ctzll(U); U &= U - 1ull;
            const int sl = (idx & 1) * SLOTB;
            *(LAS u32x4*)(lds + L_K + sl + kdst) = rk; *(LAS u32x4*)(lds + L_V + sl + vdst) = rv;
            __syncthreads();
            if (U) { const int jn = __builtin_ctzll(U); ATT_LOAD(1, jn, rk, rv); }
            const bool rowok = tvalid && ((mysel >> j) & 1ull);
            if (__any(rowok)) { const bool near = (tqmin - (64 * j + 63)) < 128;
                tile_step(lds + L_K + sl, lds + L_V + sl, qr, o, m, l, wsf, tq, 64 * j, 1 << 30, rowok, near, !near, btl, bfar, lane); }
            ++idx; }
        const float L = sum_halves(l);
        add_scaled<false>(resl, o, L > 0.f ? gate_s / L : 0.f, wsf, lane, r32, hi);
    }
    __syncthreads();
    {
        f32x16 o[2]; o[0] = (f32x16){}; o[1] = (f32x16){}; float m = 0.f, l = 0.f;
        const int jlo = SAMPLE ? 0 : (qt >= 8 ? qt - 8 : 0), jhi = SAMPLE ? 8 : qt, kb0 = SAMPLE ? PAST - 512 : 0;
        u32x4 rk, rv; int idx = 0;
        ATT_LOAD(2, jlo, rk, rv);
        for (int j = jlo; j <= jhi; ++j) {
            const int sl = (idx & 1) * SLOTB;
            *(LAS u32x4*)(lds + L_K + sl + kdst) = rk; *(LAS u32x4*)(lds + L_V + sl + vdst) = rv;
            __syncthreads();
            if (j < jhi) { ATT_LOAD(2, j + 1, rk, rv); }
            const int kbase = kb0 + 64 * j; const bool near = (tqmin - (kbase + 63)) < 128;
            const bool allin = !near && (tqmax - kbase) <= 512;
            if (!SAMPLE || half == 0) tile_step(lds + L_K + sl, lds + L_V + sl, qr, o, m, l, wsf, tq, kbase, 512, tvalid, near, allin, btl, bfar, lane);
            ++idx; }
        const float L = sum_halves(l);
        add_scaled<false>(resl, o, L > 0.f ? gate_w / L : 0.f, wsf, lane, r32, hi);
    }
#undef ATT_LOAD
    bf16* AO = (bf16*)(ws + WS_AO);
#pragma unroll
    for (int r = 0; r < 16; ++r) { const int q = crow(r, hi);
        if (SAMPLE) { if (half == 0 && q < 4) { bf16* op = AO + (size_t)(NP + b * DS + q) * DM + head * 64 + r32; op[0] = (bf16)f2bf(resl[r * 64 + lane]); op[32] = (bf16)f2bf(resl[(16 + r) * 64 + lane]); } }
        else { bf16* op = AO + (size_t)(b * SEQ + 64 * qt + 32 * half + q) * DM + head * 64 + r32; op[0] = (bf16)f2bf(resl[r * 64 + lane]); op[32] = (bf16)f2bf(resl[(16 + r) * 64 + lane]); } }
}

__device__ __forceinline__ void attn_phase(const Params& P, const Frame& F) {
    { const float* bt = (const float*)(P.ws + WS_BIAS); LAS float* d = (LAS float*)(F.lds + L_BT); for (int e = F.tid; e < 8 * 136; e += NTHREADS) d[e] = bt[e] - bt[(e / 136) * 136 + 128]; }
    __syncthreads();
    unsigned* ctr = (unsigned*)(P.ws + WS_CTL + 2048);
    volatile LAS unsigned* slot = (volatile LAS unsigned*)(F.lds + L_UNI) + 2;
#pragma unroll 1
    for (;;) {
        if (F.tid == 0) *slot = __hip_atomic_fetch_add(ctr, 1u, __ATOMIC_RELAXED, __HIP_MEMORY_SCOPE_AGENT);
        __syncthreads();
        const unsigned u = *slot;
        __syncthreads();
        if (u >= 768u) break;
        if (u < 256u) { const Frame Fu = launder(F); attn_unit<true>(P, Fu, (int)(u >> 1), (int)(u & 1u), 0); }
        else { const unsigned w = u - 256u; const int qt = 31 - (int)(w >> 4), bh = (int)(w & 15u); const Frame Fu = launder(F); attn_unit<false>(P, Fu, bh >> 1, bh & 1, qt); }
    }
    __syncthreads();
}
}
namespace ssm {
constexpr int L_SLOC = 0  , L_SPREV = 32768  , L_U = 51200  , L_END = L_U + 64 * 1040;
__device__ __forceinline__ void prompt_unit(const Params& P, const Frame& F, int b, int g) {
    unsigned char* ws = P.ws; LAS char* lds = (LAS char*)F.lds;
    const int tid = F.tid, lane = F.lane, wave = F.wave, r32 = lane & 31, hi = lane >> 5;
    const bf16* U = (const bf16*)(ws + WS_U); const bf16* PT = (const bf16*)(ws + WS_PT) + (size_t)g * 128 * 512;
    const bf16* TZ = (const bf16*)(ws + WS_TZ) + (size_t)g * 512 * 512; const bf16* WC = (const bf16*)(ws + WS_WC) + (size_t)g * 512 * 128;
    LAS float* sloc = (LAS float*)(lds + L_SLOC); LAS bf16* sprev = (LAS bf16*)(lds + L_SPREV); LAS char* ul = lds + L_U;
    const int mt = wave & 1;
    __syncthreads();
    {
#pragma unroll
      for (int i = 0; i < 8; ++i) { const int p = tid + NTHREADS * i, t = p >> 1, h = p & 1;
          *(LAS u32x4*)(ul + (t >> 5) * 1040 + (t & 31) * 32 + h * 16) = *(const u32x4*)(U + (size_t)(b * SEQ + t) * 512 + g * 16 + 8 * h); } }
    __syncthreads();
    const LAS char* arow = ul + (32 * mt + r32) * 1040 + hi * 16;
    { const int nt = wave >> 1; f32x16 acc = (f32x16){}; const bf16* brow = PT + (size_t)(32 * nt + r32) * 512 + 8 * hi;
#pragma unroll 8
      for (int ks = 0; ks < 32; ++ks) { const bf16x8 a = *(const LAS bf16x8*)(arow + ks * 32), bb = *(const bf16x8*)(brow + ks * 16);
          acc = __builtin_amdgcn_mfma_f32_32x32x16_bf16(a, bb, acc, 0, 0, 0); }
#pragma unroll
      for (int r = 0; r < 16; ++r) sloc[(32 * mt + att::crow(r, hi)) * 128 + 32 * nt + r32] = acc[r]; }
    __syncthreads();
    if (tid < 64) { const int p = tid; const float* abl = (const float*)(ws + WS_ABL) + (g * 64 + p) * 2; const float ar = abl[0], ai = abl[1]; float sr = 0.f, si = 0.f;
        for (int k = 0; k < 64; ++k) { sprev[k * 136 + p] = (bf16)f2bf(sr); sprev[k * 136 + 64 + p] = (bf16)f2bf(si);
            const float lr = sloc[k * 128 + p], li = sloc[k * 128 + 64 + p]; const float nr = ar * sr - ai * si + lr, ni = ar * si + ai * sr + li; sr = nr; si = ni; }
        P.out[O_SREP + (size_t)(b * 32 + g) * 64 + p] = sr; P.out[O_SIMP + (size_t)(b * 32 + g) * 64 + p] = si; }
    __syncthreads();
    { const int nq = wave >> 1; f32x16 acc[4];
#pragma unroll
      for (int e = 0; e < 4; ++e) acc[e] = (f32x16){};
#pragma unroll 4
      for (int ks = 0; ks < 32; ++ks) { const bf16x8 a = *(const LAS bf16x8*)(arow + ks * 32);
#pragma unroll
          for (int e = 0; e < 4; ++e) { const int nt = nq * 4 + e; if (2 * nt + 1 >= ks) { const bf16x8 bb = *(const bf16x8*)(TZ + (size_t)(32 * nt + r32) * 512 + ks * 16 + 8 * hi);
              acc[e] = __builtin_amdgcn_mfma_f32_32x32x16_bf16(a, bb, acc[e], 0, 0, 0); } } }
#pragma unroll
      for (int ks = 0; ks < 8; ++ks) { const bf16x8 a = *(const LAS bf16x8*)(sprev + (32 * mt + r32) * 136 + ks * 16 + 8 * hi);
#pragma unroll
          for (int e = 0; e < 4; ++e) { const int nt = nq * 4 + e; const bf16x8 bb = *(const bf16x8*)(WC + (size_t)(32 * nt + r32) * 128 + ks * 16 + 8 * hi);
              acc[e] = __builtin_amdgcn_mfma_f32_32x32x16_bf16(a, bb, acc[e], 0, 0, 0); } }
      bf16* YG = (bf16*)(ws + WS_YG);
#pragma unroll
      for (int e = 0; e < 4; ++e) { const int n = 32 * (nq * 4 + e) + r32, j = n >> 4, c = n & 15, ch = g * 16 + c; const float dsk = P.in[I_SD][ch];
#pragma unroll
          for (int r = 0; r < 16; ++r) { const int chunk = 32 * mt + att::crow(r, hi); const size_t row = (size_t)b * SEQ + chunk * 32 + j;
              const float y = acc[e][r] + dsk * bf2f(*(const LAS bf16*)(ul + chunk * 1040 + j * 32 + c * 2)); YG[row * 512 + ch] = (bf16)f2bf(gelu_tanh(y)); } } }
}
__device__ __forceinline__ void sample_wave(const Params& P, const Frame& F, int gw, int NGW, LAS float* sw  , LAS float* cw  ) {
    unsigned char* ws = P.ws; const int lane = F.lane, p = lane, t = lane >> 4, c = lane & 15;
    const bool gconst = (NGW & 31) == 0; int gcur = -1;
    float ar = 0.f, ai = 0.f, br[16], bi[16], dsk = 0.f;
#pragma unroll
    for (int i = 0; i < 16; ++i) { br[i] = 0.f; bi[i] = 0.f; }
#pragma unroll 1
    for (int pr = gw; pr < DB * 32; pr += NGW) { const int b = pr >> 5, g = pr & 31;
        if (g != gcur) { gcur = g;
            const float* abt = (const float*)(ws + WS_ABT) + (g * 64 + p) * 2; ar = abt[0]; ai = abt[1];
            const float* bbt = (const float*)(ws + WS_BBT) + (size_t)(g * 64 + p) * 32;
#pragma unroll
            for (int c4 = 0; c4 < 8; ++c4) { const f32x4 v = *(const f32x4*)(bbt + 4 * c4); br[2 * c4] = v[0]; bi[2 * c4] = v[1]; br[2 * c4 + 1] = v[2]; bi[2 * c4 + 1] = v[3]; }
            LDS_WAIT();
#pragma unroll
            for (int cc = 0; cc < 16; ++cc) { cw[cc * 65 + p] = P.in[I_CRE][(size_t)(g * 16 + cc) * 64 + p]; cw[1040 + cc * 65 + p] = P.in[I_CIM][(size_t)(g * 16 + cc) * 64 + p]; }
            dsk = P.in[I_SD][g * 16 + c]; LDS_WAIT(); (void)gconst; }
        const bf16* U = (const bf16*)(ws + WS_U) + (size_t)(NP + b * DS) * 512 + g * 16;
        float sr = P.in[I_SRE][(size_t)(b * 32 + g) * 64 + p], si = P.in[I_SIM][(size_t)(b * 32 + g) * 64 + p];
#pragma unroll
        for (int tt = 0; tt < DS; ++tt) { const u32x4 u0 = *(const u32x4*)(U + (size_t)tt * 512), u1 = *(const u32x4*)(U + (size_t)tt * 512 + 8);
            const float uu[16] = {bflo(u0.x), bfhi(u0.x), bflo(u0.y), bfhi(u0.y), bflo(u0.z), bfhi(u0.z), bflo(u0.w), bfhi(u0.w), bflo(u1.x), bfhi(u1.x), bflo(u1.y), bfhi(u1.y), bflo(u1.z), bfhi(u1.z), bflo(u1.w), bfhi(u1.w)};
            float xr = ar * sr - ai * si, xi = ar * si + ai * sr;
#pragma unroll
            for (int cc = 0; cc < 16; ++cc) { xr += br[cc] * uu[cc]; xi += bi[cc] * uu[cc]; }
            sr = xr; si = xi; sw[(tt * 64 + p) * 2] = sr; sw[(tt * 64 + p) * 2 + 1] = si; }
        P.out[O_SRES + (size_t)(b * 32 + g) * 64 + p] = sr; P.out[O_SIMS + (size_t)(b * 32 + g) * 64 + p] = si;
        LDS_WAIT();
        float y = 0.f;
#pragma unroll 8
        for (int pp = 0; pp < 64; ++pp) y += cw[c * 65 + pp] * sw[(t * 64 + pp) * 2] - cw[1040 + c * 65 + pp] * sw[(t * 64 + pp) * 2 + 1];
        const size_t row = (size_t)NP + b * DS + t; const int ch = g * 16 + c; const float uv = bf2f(((const bf16*)(ws + WS_U))[row * 512 + ch]);
        y = gelu_tanh(y + dsk * uv); ((bf16*)(ws + WS_YG))[row * 512 + ch] = (bf16)f2bf(y);
        LDS_WAIT(); }
}
}

__device__ __forceinline__ void cmp_combine_unit(const Params& P, const Frame& F, int ba, int hkv, int type) {
    unsigned char* ws = P.ws; const int lane = F.lane, wave = F.wave, r32 = lane & 31, hi = lane >> 5, mt = wave >> 1, nt = wave & 1;
    const bf16* OC = (const bf16*)(ws + WS_OUTC) + (size_t)(type * 2 + hkv) * NBA * 128 * 256; const float* cc = (const float*)(ws + WS_CCON) + type * 128;
    const bf16* W2 = (const bf16*)(ws + WS_WC2) + (size_t)type * 64 * 128;
    const int i = 32 * mt + r32, i1 = i < 127 ? i + 1 : 127;
    const bf16* lo = OC + (size_t)(ba * 128 + i) * 256 + 8 * hi; const bf16* hh = OC + (size_t)(ba * 128 + i1) * 256 + 128 + 8 * hi;
    f32x16 acc = (f32x16){};
#pragma unroll 2
    for (int ks = 0; ks < 8; ++ks) { const u32x4 a = *(const u32x4*)(lo + ks * 16), c = *(const u32x4*)(hh + ks * 16); const f32x4 k0 = *(const f32x4*)(cc + ks * 16 + 8 * hi), k1 = *(const f32x4*)(cc + ks * 16 + 8 * hi + 4);
        u32x4 w; w.x = pk2(gelu_tanh(bflo(a.x) + bflo(c.x) + k0[0]), gelu_tanh(bfhi(a.x) + bfhi(c.x) + k0[1])); w.y = pk2(gelu_tanh(bflo(a.y) + bflo(c.y) + k0[2]), gelu_tanh(bfhi(a.y) + bfhi(c.y) + k0[3]));
        w.z = pk2(gelu_tanh(bflo(a.z) + bflo(c.z) + k1[0]), gelu_tanh(bfhi(a.z) + bfhi(c.z) + k1[1])); w.w = pk2(gelu_tanh(bflo(a.w) + bflo(c.w) + k1[2]), gelu_tanh(bfhi(a.w) + bfhi(c.w) + k1[3]));
        const bf16x8 bb = *(const bf16x8*)(W2 + (size_t)(32 * nt + r32) * 128 + ks * 16 + 8 * hi);
        acc = __builtin_amdgcn_mfma_f32_32x32x16_bf16(__builtin_bit_cast(bf16x8, w), bb, acc, 0, 0, 0); }
    bf16* O = (bf16*)(ws + (type ? WS_VC : WS_KC)) + (size_t)(ba * 2 + hkv) * 128 * 64;
#pragma unroll
    for (int r = 0; r < 16; ++r) { const int row = 32 * mt + att::crow(r, hi); O[(size_t)row * 64 + 32 * nt + r32] = row < 127 ? (bf16)f2bf(acc[r]) : (bf16)0; }
}

__device__ __forceinline__ void ssm_phase(const Params& P, const Frame& F) {
    { LAS float* sw = (LAS float*)F.lds + F.wave * 512; LAS float* cw = (LAS float*)(F.lds + 16384) + F.wave * 2080;
      const bool std_grid = F.G == 256; const int c0 = (int)blockIdx.x, nb = std_grid ? 240 : F.G, ib = std_grid ? c0 - 16 : c0;
      if (ib >= 0) ssm::sample_wave(P, F, ib * NWAVES + F.wave, nb * NWAVES, sw, cw); }
    __builtin_amdgcn_sched_barrier(0);
    __syncthreads();
    const int c = (int)blockIdx.x, first = (F.G == 256) ? (c >= 16 ? c - 16 : 240 + c) : c;
#pragma unroll 1
    for (int v = first; v < 256; v += F.G) { const Frame Fu = launder(F); ssm::prompt_unit(P, Fu, v >> 5, v & 31); }
    __syncthreads();
}
__device__ __forceinline__ void misc_phase(const Params& P, const Frame& F) {
#pragma unroll 1
    for (int u = blockIdx.x; u < NBA * 4; u += F.G) { const Frame Fu = launder(F); cmp_combine_unit(P, Fu, u >> 2, (u >> 1) & 1, u & 1); }
}

template <int KIND, int NSPLIT> __device__ __forceinline__ void fix_phase(const Params& P, const Frame& F, const float* base, float scale, const float* ssq_in, float* ssq_out) {
    unsigned char* ws = P.ws; const float* part = (const float*)(ws + WS_T1); float* xr = (float*)(ws + WS_XR); bf16* xb = (bf16*)(ws + WS_XB); const bf16* pp = (const bf16*)(ws + WS_PP);
    const int gw = F.vcu * NWAVES + F.wave, NGW = F.G * NWAVES, lane = F.lane;
    for (int it = gw; it < NSR * 4; it += NGW) { const int sr = it >> 2, j = it & 3; const size_t row = (size_t)NP + sr; const int col = 256 * j + 4 * lane;
        f32x4 pv[NSPLIT];
#pragma unroll
        for (int ks = 0; ks < NSPLIT; ++ks) pv[ks] = *(const f32x4*)(part + ((size_t)ks * NSR + sr) * DM + col);
        f32x4 a = pv[0];
#pragma unroll
        for (int ks = 1; ks < NSPLIT; ++ks) a = a + pv[ks];
        f32x4 x;
        if (KIND == 0) x = *(const f32x4*)(base + (size_t)sr * DM + col) + a * scale;
        else { const float rs = rstd_of(ssq_in[row]); const u32x2 w = *(const u32x2*)(pp + row * DM + col); x = *(const f32x4*)(xr + row * DM + col);
            x[0] += sigmoidf_(a[0] * rs) * bflo(w.x); x[1] += sigmoidf_(a[1] * rs) * bfhi(w.x); x[2] += sigmoidf_(a[2] * rs) * bflo(w.y); x[3] += sigmoidf_(a[3] * rs) * bfhi(w.y); }
        *(f32x4*)(xr + row * DM + col) = x; u32x2 o; o.x = pk2(x[0], x[1]); o.y = pk2(x[2], x[3]); *(u32x2*)(xb + row * DM + col) = o;
        const float ss = wave_sum((x[0] * x[0] + x[1] * x[1]) + (x[2] * x[2] + x[3] * x[3])); if (lane == 0) atomicAdd(ssq_out + row, ss); }
}

__device__ __forceinline__ void final_phase(const Params& P, const Frame& F) {
    const float* xr = (const float*)(P.ws + WS_XR); const float* ssq = (const float*)(P.ws + WS_SSQ) + 3 * MR; const float* gf = P.in[I_GFIN];
    const int gw = F.vcu * NWAVES + F.wave, NGW = F.G * NWAVES, lane = F.lane;
    f32x4 gv[4];
#pragma unroll
    for (int j = 0; j < 4; ++j) gv[j] = *(const f32x4*)(gf + 256 * j + 4 * lane);
    for (int m = gw; m < MR; m += NGW) { const float rs = rstd_of(ssq[m]);
#pragma unroll
        for (int j = 0; j < 4; ++j) { const f32x4 v = *(const f32x4*)(xr + (size_t)m * DM + 256 * j + 4 * lane); *(f32x4*)(P.out + (size_t)m * DM + 256 * j + 4 * lane) = v * rs * gv[j]; } }
}
#define XB_TMO      128
#define XB_XCNT(j)  (256  + 64 * (j))
#define XB_XSUB(j)  (1280 + 64 * (j))
#define XB_XGEN(j)  (2304 + 64 * (j))
#define XB_TOP      3328
#define XB_TOPGEN   3392
#define XCD_BAR_WORDS 3456
#define XB_SPIN_CAP (1u << 18)

__device__ __forceinline__ unsigned xb_ld(unsigned* p)              { return __hip_atomic_load(p, __ATOMIC_RELAXED, __HIP_MEMORY_SCOPE_AGENT); }
__device__ __forceinline__ unsigned xb_add(unsigned* p, unsigned v) { return __hip_atomic_fetch_add(p, v, __ATOMIC_RELAXED, __HIP_MEMORY_SCOPE_AGENT); }
__device__ __forceinline__ unsigned xb_xcc_id() { return (unsigned)__builtin_amdgcn_s_getreg((3 << 11) | 20) & 0xFu; }
#define XB_SPIN(cond, bar) do { unsigned _sp = 0; while (cond) { __builtin_amdgcn_s_sleep(1); \
    if ((++_sp & 255u) == 0u) { if (xb_ld(&(bar)[XB_TMO])) break; if (_sp > XB_SPIN_CAP) { atomicAdd(&(bar)[XB_TMO], 1u); break; } } } } while (0)

struct XcdBarrier {
    unsigned* bar; unsigned x;
    volatile LAS unsigned* st;
};

__device__ __forceinline__ XcdBarrier xcd_barrier_post(unsigned* bar, volatile LAS unsigned* st) {
    XcdBarrier b; b.bar = bar; b.x = xb_xcc_id(); b.st = st;
    if (threadIdx.x == 0) (void)xb_add(&bar[XB_XCNT(b.x)], 1u);
    return b;
}
__device__ __forceinline__ void xcd_barrier_complete(unsigned* bar, unsigned x, unsigned& nloc, unsigned& nx) {
    const unsigned G = gridDim.x * gridDim.y * gridDim.z;
    unsigned sum, cnt, mine, sp = 0u;
    for (;;) {
        sum = 0u; cnt = 0u; mine = 0u;
#pragma unroll
        for (unsigned j = 0; j < 16; ++j) { const unsigned c = xb_ld(&bar[XB_XCNT(j)]); sum += c; cnt += (c > 0u) ? 1u : 0u; mine = (j == x) ? c : mine; }
        if (sum == G) break;
        __builtin_amdgcn_s_sleep(1);
        if ((++sp & 255u) == 0u) { if (xb_ld(&bar[XB_TMO])) break; if (sp > XB_SPIN_CAP) { atomicAdd(&bar[XB_TMO], 1u); break; } }
    }
    nloc = mine > 0u ? mine : 1u; nx = cnt > 0u ? cnt : 1u;
}

__device__ __forceinline__ void xcd_barrier(const XcdBarrier& b) {
    asm volatile("s_waitcnt vmcnt(0)" ::: "memory");
    __syncthreads();
    if (threadIdx.x == 0) {
        unsigned* bar = b.bar;
        __builtin_amdgcn_s_waitcnt(0);
        unsigned nloc = b.st[0], nx = b.st[1];
        if (nloc == 0u) { xcd_barrier_complete(bar, b.x, nloc, nx); b.st[0] = nloc; b.st[1] = nx; }
        const unsigned old = xb_add(&bar[XB_XSUB(b.x)], 1u);
        const unsigned gen = old / nloc;
        if (old + 1u == (gen + 1u) * nloc) {
            __builtin_amdgcn_fence(__ATOMIC_RELEASE, "agent");
            asm volatile("s_waitcnt vmcnt(0)" ::: "memory");
            const unsigned og = xb_add(&bar[XB_TOP], 1u);
            const unsigned tg = og / nx;
            if (og + 1u == (tg + 1u) * nx) xb_add(&bar[XB_TOPGEN], 1u);
            else XB_SPIN(xb_ld(&bar[XB_TOPGEN]) == tg, bar);
            __builtin_amdgcn_fence(__ATOMIC_ACQUIRE, "agent");
            xb_add(&bar[XB_XGEN(b.x)], 1u);
            asm volatile("s_waitcnt vmcnt(0)" ::: "memory");
        } else {
            XB_SPIN(xb_ld(&bar[XB_XGEN(b.x)]) == gen, bar);
            __builtin_amdgcn_fence(__ATOMIC_ACQUIRE, "agent");
            asm volatile("s_waitcnt vmcnt(0)" ::: "memory");
        }
    }
    __syncthreads();
}


constexpr int LDS_BYTES = 147456;
enum Phase { PH_PRO = 0, PH_GU1, PH_D1, PH_FIX1, PH_WIN, PH_CMPG, PH_SSM, PH_MISC, PH_GLU, PH_ATT, PH_MG1, PH_MG2, PH_WOUT, PH_FIX2, PH_GU2, PH_D2, PH_FIX3, PH_PPROJ, PH_PGATE, PH_FIX4, PH_FINAL, PH_N };
constexpr int SPLIT_D = 11, SPLIT_O = 4;

#ifndef PH_MASK
#define PH_MASK 0x1FFFFF
#endif
#define EN(k) (((PH_MASK) >> (k)) & 1)
template <int PH> __device__ __forceinline__ void run_phase(const Params& P, const Frame& F, unsigned char* ws) {
    using namespace pg8;
    float* ssq1 = (float*)(ws + WS_SSQ); float* ssq2 = ssq1 + MR; float* ssq3 = ssq2 + MR; float* ssq4 = ssq3 + MR; const float* ssq0 = (const float*)(ws + WS_SSQ0);
    bf16* XB = (bf16*)(ws + WS_XB); float* XR = (float*)(ws + WS_XR); bf16* H = (bf16*)(ws + WS_H);
    Gemm g{}; g.vt = 0; g.vstride = 0; g.bdiv = 0; g.kstepA = BK; g.M = MR;
    StaticOrder S;
    if constexpr (!EN(PH)) { return; }
    else if constexpr (PH == PH_PRO) prologue(P, F);
    else if constexpr (PH == PH_GU1 || PH == PH_GU2) { constexpr bool two = PH == PH_GU2;
        g.A = XB; g.Bt = (const bf16*)(ws + (two ? WS_WGU2 : WS_WGU1)); g.N = 2 * FF; g.K = DM; g.lda = DM; S.init(MR, 2 * FF, F.G, (int)blockIdx.x, DM);
        EpiSwiglu E{H, FF, two ? ssq2 : ssq0};
        gemm_phase<EpiSwiglu, StaticOrder, true, true>(F.lds, g, S, E); }
    else if constexpr (PH == PH_D1 || PH == PH_D2 || PH == PH_WOUT) {
        EpiResid E;
        if constexpr (PH == PH_D1) { g.A = H; g.Bt = (const bf16*)(ws + WS_WD1); g.K = FF; g.lda = FF; E = EpiResid{P.in[I_XP], P.in[I_XS], XR, XB, ssq1, 0.5f, nullptr}; }
        else if constexpr (PH == PH_D2) { g.A = H; g.Bt = (const bf16*)(ws + WS_WD2); g.K = FF; g.lda = FF; E = EpiResid{XR, XR + (size_t)NP * DM, XR, XB, ssq3, 0.5f, (float*)(ws + WS_T1)}; }
        else { g.A = (const bf16*)(ws + WS_TT); g.Bt = (const bf16*)(ws + WS_WOUT); g.K = DM; g.lda = DM; E = EpiResid{XR, XR + (size_t)NP * DM, XR, XB, ssq2, 1.0f, (float*)(ws + WS_T1)}; }
        g.N = DM; if constexpr (PH == PH_D1) S.init(MR, DM, F.G, (int)blockIdx.x, g.K); else S.init(MR, DM, F.G, (int)blockIdx.x, g.K, NP, PH == PH_WOUT ? SPLIT_O : SPLIT_D);
        gemm_phase<EpiResid, StaticOrder, true, true>(F.lds, g, S, E);
        if constexpr (PH == PH_D1) { const int extra = S.nwg - F.G;
            if (extra >= 0 && extra < F.G) { if ((int)blockIdx.x >= extra) { const int nb = F.G - extra, ib = (int)blockIdx.x - extra;
                    for (int it = ib; it < 256; it += nb) ssm_tables_item(P, (LAS float*)F.lds, it, F.tid);
                    background_copy(P, ib * NWAVES + F.wave, nb * NWAVES, F.lane, (LAS float*)(F.lds + F.wave * 16384)); } }
            else { for (int it = blockIdx.x; it < 256; it += F.G) ssm_tables_item(P, (LAS float*)F.lds, it, F.tid);
                background_copy(P, (int)blockIdx.x * NWAVES + F.wave, F.G * NWAVES, F.lane, (LAS float*)(F.lds + F.wave * 16384)); } } }
    else if constexpr (PH == PH_WIN) { g.A = XB; g.Bt = (const bf16*)(ws + WS_WIN); g.N = NIN; g.K = DM; g.lda = DM; S.init(MR, NIN, F.G, (int)blockIdx.x, DM);
        EpiWin E{ssq1, P.out, (bf16*)(ws + WS_Q), (bf16*)(ws + WS_CCB) + (size_t)DB * 2048 * 256, (bf16*)(ws + WS_KVS), (bf16*)(ws + WS_KVW), (bf16*)(ws + WS_U), (bf16*)(ws + WS_MG), (float*)(ws + WS_NG)};
        gemm_phase<EpiWin, StaticOrder, true, true>(F.lds, g, S, E); }
    else if constexpr (PH == PH_CMPG) { g.A = (const bf16*)(ws + WS_CCB); g.Bt = (const bf16*)(ws + WS_WC1); g.M = 4 * NBA * 128; g.N = 256; g.K = 1024; g.lda = 4096; g.kstepA = 256; g.vt = NBA * 128 / 256; g.vstride = 64; g.bdiv = 2 * (NBA * 128 / 256);
        EpiPlain E{(bf16*)(ws + WS_OUTC), 256}; S.init(4 * NBA * 128, 256, F.G, (int)blockIdx.x, 1024);
        gemm_phase<EpiPlain, StaticOrder, true, true>(F.lds, g, S, E); }
    else if constexpr (PH == PH_PPROJ) { g.A = (const bf16*)(ws + WS_PB); g.Bt = (const bf16*)(ws + WS_WPP); g.N = DM; g.K = PLE; g.lda = PLE; EpiPlain E{(bf16*)(ws + WS_PP), DM}; S.init(MR, DM, F.G, (int)blockIdx.x, PLE);
        gemm_phase<EpiPlain, StaticOrder, true, true>(F.lds, g, S, E); }
    else if constexpr (PH == PH_SSM) ssm_phase(P, F);
    else if constexpr (PH == PH_MISC) misc_phase(P, F);
    else if constexpr (PH == PH_ATT) att::attn_phase(P, F);
    else if constexpr (PH == PH_GLU) { g.A = (const bf16*)(ws + WS_YG); g.Bt = (const bf16*)(ws + WS_WGLU); g.N = 512; g.K = 512; g.lda = 512; S.init(MR, 512, F.G, (int)blockIdx.x, 512);
        EpiGlu E{(const bf16*)(ws + WS_YG), (bf16*)(ws + WS_AO)};
        gemm_phase<EpiGlu, StaticOrder, true, true>(F.lds, g, S, E);
    }
    else if constexpr (PH == PH_MG1) { g.A = (const bf16*)(ws + WS_AO); g.Bt = (const bf16*)(ws + WS_WBA); g.N = DM; g.K = DM; g.lda = DM; S.init(MR, DM, F.G, (int)blockIdx.x, DM);
        EpiMerge E{(const bf16*)(ws + WS_MG), (bf16*)(ws + WS_TT)};
        gemm_phase<EpiMerge, StaticOrder, true, true>(F.lds, g, S, E); }
    else if constexpr (PH == PH_PGATE) { g.A = XB; g.Bt = (const bf16*)(ws + WS_WPG); g.N = DM; g.K = DM; g.lda = DM; S.init(MR, DM, F.G, (int)blockIdx.x, DM, NP, SPLIT_O);
        EpiPleGate E{ssq3, (const bf16*)(ws + WS_PP), XR, ssq4, (float*)(ws + WS_T1)};
        gemm_phase<EpiPleGate, StaticOrder, true, true>(F.lds, g, S, E); }
    else if constexpr (PH == PH_FIX2) fix_phase<0, SPLIT_O>(P, F, XR + (size_t)NP * DM, 1.0f, nullptr, ssq2);
    else if constexpr (PH == PH_FIX3) fix_phase<0, SPLIT_D>(P, F, XR + (size_t)NP * DM, 0.5f, nullptr, ssq3);
    else if constexpr (PH == PH_FIX4) fix_phase<1, SPLIT_O>(P, F, nullptr, 0.f, ssq3, ssq4);
    else if constexpr (PH == PH_FINAL) final_phase(P, F);
}

__global__ void __launch_bounds__(NTHREADS, 2) mega_fwd(Params P) {
    extern __shared__ __attribute__((aligned(16))) unsigned char lds_raw[];
    Frame F0; F0.lds = (LAS unsigned char*)lds_raw; F0.tid = threadIdx.x; F0.lane = F0.tid & 63; F0.wave = __builtin_amdgcn_readfirstlane(F0.tid >> 6);
    F0.G = gridDim.x; { const int bx = blockIdx.x; F0.vcu = (F0.G % 8 == 0) ? (bx % 8) * (F0.G / 8) + bx / 8 : bx; }
    const int lo = P.ph_lo, hi = P.ph_hi;
    volatile LAS unsigned* bst = (volatile LAS unsigned*)(F0.lds + LDS_BYTES - 64);
    if (F0.tid < 2) bst[F0.tid] = 0u;
    __syncthreads();
    XcdBarrier bar; bar.bar = (unsigned*)(P.ws + WS_CTL) + 1024; bar.x = 0; bar.st = bst;
    if (P.coop) bar = xcd_barrier_post((unsigned*)(P.ws + WS_CTL) + 1024, bst);
#define RUN(k) if ((k) != PH_FIX1 && (k) != PH_MG2 && lo <= (k) && (k) < hi) { Frame F = launder(F0); unsigned char* ws = P.ws; asm volatile("" : "+s"(ws)); run_phase<k>(P, F, ws); if ((k) == PH_CMPG || (k) == PH_MISC || (k) == PH_FIX3) { __builtin_amdgcn_sched_barrier(0); __syncthreads(); asm volatile("" ::: "memory"); } else if ((k) + 1 < hi && P.coop) { if (P.coop == 2) cg::this_grid().sync(); else xcd_barrier(bar); } }
    RUN(0) RUN(1) RUN(2) RUN(3) RUN(4) RUN(5) RUN(6) RUN(7) RUN(8) RUN(9) RUN(10) RUN(11) RUN(12) RUN(13) RUN(14) RUN(15) RUN(16) RUN(17) RUN(18) RUN(19) RUN(20)
#undef RUN
}

extern "C" void kernel_launch(void* const* d_in, const int* in_sizes, int n_in, void* d_out, int out_size, void* d_ws, size_t ws_size, hipStream_t stream) {
    static int grid = 0;
    if (grid == 0) {
        if (n_in != 45 || (size_t)out_size != O_END || ws_size < WS_END) { fprintf(stderr, "kernel_launch: unexpected shapes: n_in %d out %d ws %zu (need %zu)\n", n_in, out_size, ws_size, (size_t)WS_END); grid = -1; return; }
        int dev = 0, cus = 0, per_cu = 0;
        (void)hipGetDevice(&dev); (void)hipDeviceGetAttribute(&cus, hipDeviceAttributeMultiprocessorCount, dev);
        if (hipFuncSetAttribute((const void*)mega_fwd, hipFuncAttributeMaxDynamicSharedMemorySize, LDS_BYTES) != hipSuccess) { fprintf(stderr, "kernel_launch: hipFuncSetAttribute failed\n"); grid = -1; return; }
        if (hipOccupancyMaxActiveBlocksPerMultiprocessor(&per_cu, (const void*)mega_fwd, NTHREADS, LDS_BYTES) != hipSuccess || per_cu < 1) { fprintf(stderr, "kernel_launch: occupancy query says %d blocks per CU\n", per_cu); per_cu = 1; }
        (void)hipGetLastError();
        grid = cus;
        if (grid <= 0) grid = 256;
    }
    if (grid < 0) return;
    (void)hipMemsetAsync((char*)d_ws + WS_CTL, 0, CTL_BYTES, stream);
    Params p{};
    for (int i = 0; i < 45; ++i) p.in[i] = (const float*)d_in[i];
    p.out = (float*)d_out; p.ws = (unsigned char*)d_ws;
    for (int n = 0; n < 128; ++n) { int bk; if (n < 16) bk = n; else { bk = 16 + (int)(std::log((double)n / 16.0) / std::log(8.0) * 16.0); if (bk > 31) bk = 31; } p.bucket[n] = (unsigned char)bk; }
#if MK_ONE_LAUNCH
    p.ph_lo = 0; p.ph_hi = PH_N; p.coop = 1;
    void* args[] = {&p};
    hipError_t e = hipLaunchCooperativeKernel((const void*)mega_fwd, dim3(grid), dim3(NTHREADS), args, LDS_BYTES, stream);
    if (e != hipSuccess) fprintf(stderr, "kernel_launch: cooperative launch failed: %s (grid %d)\n", hipGetErrorString(e), grid);
#else
    for (int ph = 0; ph < PH_N; ++ph) { p.ph_lo = ph; p.ph_hi = ph + 1; p.coop = 0; hipLaunchKernelGGL(mega_fwd, dim3(grid), dim3(NTHREADS), LDS_BYTES, stream, p); }
#endif
}
```

```cpp
#include <hip/hip_runtime.h>
#include <hip/hip_cooperative_groups.h>
#include <cstdio>
#include <cstdint>
#include <cmath>
namespace cg = cooperative_groups;

#define LAS __attribute__((address_space(3)))
#define GAS __attribute__((address_space(1)))
typedef unsigned short bf16;
typedef short bf16x8 __attribute__((ext_vector_type(8)));
typedef short s16x4 __attribute__((ext_vector_type(4)));
typedef float f32x4 __attribute__((ext_vector_type(4)));
typedef float f32x2 __attribute__((ext_vector_type(2)));
typedef float f32x16 __attribute__((ext_vector_type(16)));
typedef unsigned u32x4 __attribute__((ext_vector_type(4)));
typedef unsigned u32x2 __attribute__((ext_vector_type(2)));

constexpr int DM = 1024, NP = 16384, NSR = 512, MR = NP + NSR;
constexpr int SEQ = 2048, NB = 8, DB = 128, DS = 4, PAST = 2048, NBA = DB + NB;
constexpr int FF = 2816, NIN = 4096, PLE = 256;
constexpr int NWAVES = 8, NTHREADS = 512;
constexpr float RMS_EPS = 1e-6f;
constexpr float LOG2E = 1.4426950408889634f;

constexpr size_t O_YP = 0, O_YS = O_YP + (size_t)NP * DM, O_KVCP = O_YS + (size_t)NSR * DM, O_KVSP = O_KVCP + (size_t)NP * 256, O_KVWP = O_KVSP + (size_t)NP * 256,
                 O_SREP = O_KVWP + (size_t)NB * 512 * 256, O_SIMP = O_SREP + NB * 32 * 64, O_KVCS = O_SIMP + NB * 32 * 64, O_KVSS = O_KVCS + (size_t)NSR * 256,
                 O_KVWS = O_KVSS + (size_t)NSR * 256, O_SRES = O_KVWS + (size_t)DB * 512 * 256, O_SIMS = O_SRES + DB * 32 * 64, O_END = O_SIMS + DB * 32 * 64;

constexpr size_t al256(size_t x) { return (x + 255) & ~(size_t)255; }
constexpr size_t WS_CTL = 0, CTL_BYTES = 2u << 20;
constexpr size_t WS_SSQ = 65536;
constexpr size_t WS_SSQ0 = CTL_BYTES;
constexpr size_t WS_WGU1 = al256(WS_SSQ0 + (size_t)MR * 4);
constexpr size_t WS_WD1 = WS_WGU1 + (size_t)2 * FF * DM * 2;
constexpr size_t WS_WIN = WS_WD1 + (size_t)DM * FF * 2;
constexpr size_t WS_WGLU = WS_WIN + (size_t)NIN * DM * 2;
constexpr size_t WS_WBA = WS_WGLU + (size_t)512 * 512 * 2;
constexpr size_t WS_WBS = WS_WBA + (size_t)DM * 512 * 2;
constexpr size_t WS_WOUT = WS_WBS + (size_t)DM * 512 * 2;
constexpr size_t WS_WGU2 = WS_WOUT + (size_t)DM * DM * 2;
constexpr size_t WS_WD2 = WS_WGU2 + (size_t)2 * FF * DM * 2;
constexpr size_t WS_WPG = WS_WD2 + (size_t)DM * FF * 2;
constexpr size_t WS_WPP = WS_WPG + (size_t)DM * DM * 2;
constexpr size_t WS_WC1 = WS_WPP + (size_t)DM * PLE * 2;
constexpr size_t WS_WC2 = WS_WC1 + (size_t)2 * 256 * 1024 * 2;
constexpr size_t WS_XB = al256(WS_WC2 + (size_t)2 * 64 * 128 * 2);
constexpr size_t WS_XR = WS_XB + (size_t)MR * DM * 2;
constexpr size_t WS_H = WS_XR + (size_t)MR * DM * 4;
constexpr size_t WS_Q = WS_H + (size_t)MR * FF * 2;
constexpr size_t WS_KVS = WS_Q + (size_t)MR * 512 * 2;
constexpr size_t WS_KVW = WS_KVS + (size_t)MR * 256 * 2;
constexpr size_t WS_U = WS_KVW + (size_t)MR * 256 * 2;
constexpr size_t WS_NG = WS_U + (size_t)MR * 512 * 2;
constexpr size_t WS_MG = al256(WS_NG + (size_t)MR * 24 * 4);
constexpr size_t WS_AO = WS_MG + (size_t)MR * 2048 * 2;
constexpr size_t WS_YG = WS_AO + (size_t)MR * DM * 2;
constexpr size_t WS_T1 = WS_YG + (size_t)MR * 512 * 2;
constexpr size_t WS_TT = WS_T1 + (size_t)MR * DM * 4;
constexpr size_t WS_PP = WS_TT + (size_t)MR * DM * 2;
constexpr size_t WS_PB = WS_PP + (size_t)MR * DM * 2;
constexpr size_t WS_CCB = WS_PB + (size_t)MR * PLE * 2;
constexpr size_t WS_OUTC = WS_CCB + (size_t)NBA * 2048 * 256 * 2;
constexpr size_t WS_KC = WS_OUTC + (size_t)4 * NBA * 128 * 256 * 2;
constexpr size_t WS_VC = WS_KC + (size_t)NBA * 2 * 128 * 64 * 2;
constexpr size_t WS_TZ = WS_VC + (size_t)NBA * 2 * 128 * 64 * 2;
constexpr size_t WS_PT = WS_TZ + (size_t)32 * 512 * 512 * 2;
constexpr size_t WS_WC = WS_PT + (size_t)32 * 128 * 512 * 2;
constexpr size_t WS_ABT = WS_WC + (size_t)32 * 512 * 128 * 2;
constexpr size_t WS_ABL = WS_ABT + 32 * 64 * 2 * 4;
constexpr size_t WS_BBT = WS_ABL + 32 * 64 * 2 * 4;
constexpr size_t WS_BIAS = WS_BBT + 32 * 64 * 16 * 2 * 4;
constexpr size_t WS_CCON = 32768;
constexpr size_t WS_END = al256(WS_BIAS + 8 * 136 * 4);

__device__ __forceinline__ unsigned f2bf(float f) { unsigned u = __builtin_bit_cast(unsigned, f); return (u + 0x7fffu + ((u >> 16) & 1u)) >> 16; }
__device__ __forceinline__ unsigned pk2(float lo, float hi) {
    typedef __bf16 bf16x2_t __attribute__((ext_vector_type(2)));
    f32x2 v = {lo, hi}; bf16x2_t b = __builtin_convertvector(v, bf16x2_t); return __builtin_bit_cast(unsigned, b); }
__device__ __forceinline__ float bflo(unsigned w) { return __builtin_bit_cast(float, w << 16); }
__device__ __forceinline__ float bfhi(unsigned w) { return __builtin_bit_cast(float, w & 0xffff0000u); }
__device__ __forceinline__ float bf2f(bf16 h) { return __builtin_bit_cast(float, (unsigned)h << 16); }
__device__ __forceinline__ float fast_exp2(float x) { return __builtin_amdgcn_exp2f(x); }
__device__ __forceinline__ float fast_rcp(float x) { return __builtin_amdgcn_rcpf(x); }
__device__ __forceinline__ float sigmoidf_(float x) { return fast_rcp(1.0f + fast_exp2(-x * LOG2E)); }
__device__ __forceinline__ float siluf_(float x) { return x * sigmoidf_(x); }
__device__ __forceinline__ float gelu_tanh(float x) { const float z = 0.7978845608028654f * (x + 0.044715f * x * x * x); return x * fast_rcp(1.0f + fast_exp2(-2.0f * LOG2E * z)); }
__device__ __forceinline__ float rstd_of(float ssq) { return 1.0f / sqrtf(ssq * (1.0f / DM) + RMS_EPS); }
#define LDS_WAIT() asm volatile("s_waitcnt lgkmcnt(0)" ::: "memory")
#ifndef MK_ONE_LAUNCH
#define MK_ONE_LAUNCH 1
#endif
namespace pg8 {
#define PG8_LAS __attribute__((address_space(3)))
typedef unsigned short bf16_t;
typedef short bf16x8 __attribute__((ext_vector_type(8)));
typedef float f32x4 __attribute__((ext_vector_type(4)));
typedef unsigned u32x4 __attribute__((ext_vector_type(4)));
constexpr int BM = 256, BK = 64, HALF = 128, HTB = HALF * BK * 2  , STAGE_BYTES = 8 * HTB, NXCD = 8, WGM = 8;

__host__ __device__ __forceinline__ int lds_byte(int r, int c) { const int st = (r >> 4) * 2 + (c >> 5), rr = r & 15, cc = c & 31, ob = rr * 64 + cc * 2; return st * 1024 + (ob ^ (((ob >> 9) & 1) << 5)); }
__host__ __device__ __forceinline__ void stage_rc(int b, int& R, int& C) { const int st = b / 1024, sb = b % 1024, swz = sb ^ (((sb >> 9) & 1) << 5); R = (st >> 1) * 16 + swz / 64; C = (st & 1) * 32 + (swz % 64) / 2; }
__host__ __device__ __forceinline__ int perm32(int rho) { const int n = rho >> 4, i = rho & 15; return 8 * (i >> 2) + 4 * n + (i & 3); }

struct Unit { int pm, pn, kt0, nt; };
struct Gemm { const bf16_t* A; const bf16_t* Bt; int M, N, K; int lda, kstepA; int vt, vstride, bdiv;
    __device__ __forceinline__ const char* a_tile(const Unit& u) const {
        const size_t off = vt ? (size_t)(u.pm / vt) * vstride + (size_t)(u.pm % vt) * 256 * lda : (size_t)u.pm * 256 * lda; return (const char*)(A + off + (size_t)u.kt0 * kstepA); }
    __device__ __forceinline__ const char* b_tile(const Unit& u) const { const int bi = bdiv ? u.pm / bdiv : u.pn; return (const char*)(Bt + (size_t)bi * 256 * K + (size_t)u.kt0 * BK); }
};

struct StaticOrder {
    int nM, nN, nwg, G, c, nMf, split, ntf, nfull, vt, vfull;
    __host__ __device__ void init(int M, int N, int G_, int c_, int K = 0, int Mfull = -1, int split_ = 1) { nM = M / BM; nN = N / BM; G = G_; c = c_; ntf = K / BK;
        nMf = Mfull < 0 ? nM : Mfull / BM; split = split_; nfull = nMf * nN; nwg = nfull + (nM - nMf) * nN * split; vt = 0; vfull = 0; }
    __host__ __device__ void init_views(int nviews, int vt_, int vfull_, int split_, int K, int G_, int c_) { nM = nviews * vt_; nN = 1; G = G_; c = c_; ntf = K / BK; vt = vt_; vfull = vfull_; split = split_;
        nMf = nM; nfull = nviews * vfull_; nwg = nfull + nviews * (vt_ - vfull_) * split_; }
    __host__ __device__ bool next(int i, Unit& u) const {
        const long L = (long)i * G + c; if (L >= nwg) return false;
        const bool sp = L >= nfull;
        const int idx = (int)L - nfull, per = nN * split, rem = idx % per, snt = ntf / split;
        int wgid = (int)L; { const int q = nfull / NXCD, r = nfull % NXCD, xcd = wgid % NXCD, off = wgid / NXCD; wgid = (xcd < r ? xcd * (q + 1) : r * (q + 1) + (xcd - r) * q) + off; }
        const int nig = WGM * nN, gid = wgid / nig, fm = gid * WGM, gsz = (nMf - fm) < WGM ? (nMf - fm) : WGM;
        const int fpm = fm + ((wgid % nig) % (gsz > 0 ? gsz : 1)), fpn = (wgid % nig) / (gsz > 0 ? gsz : 1);
        Unit r; r.pm = sp ? nMf + idx / per : fpm; r.pn = sp ? rem / split : fpn; r.kt0 = sp ? (rem % split) * snt : 0; r.nt = sp ? snt : ntf;
        if (vt) { const int vrest = vt - vfull, u16 = idx / split, fl = (int)L;
            r.pm = sp ? (u16 / vrest) * vt + vfull + (u16 % vrest) : (fl / vfull) * vt + (fl % vfull); r.pn = 0; r.kt0 = sp ? (idx % split) * snt : 0; }
        u = r; return true;
    }
    __device__ __forceinline__ void a_ready(const Unit&) const {}
    __device__ __forceinline__ void done(const Unit&) const {}
};

typedef const f32x4 (&AccRef)[2][2][4][2];
#define EPI_ROW(ai, m) (u.pm * BM + (ai) * HALF + wr * 64 + (m) * 16 + fr)
#define EPI_COL(bj) (u.pn * BM + (bj) * HALF + wc * 32 + 8 * fq)
__device__ __forceinline__ u32x4 pack8(f32x4 a, f32x4 b) { u32x4 w; w.x = pk2(a[0], a[1]); w.y = pk2(a[2], a[3]); w.z = pk2(b[0], b[1]); w.w = pk2(b[2], b[3]); return w; }
__device__ __forceinline__ void unpack8(u32x4 w, f32x4& a, f32x4& b) { a = (f32x4){bflo(w.x), bfhi(w.x), bflo(w.y), bfhi(w.y)}; b = (f32x4){bflo(w.z), bfhi(w.z), bflo(w.w), bfhi(w.w)}; }

struct EpiPlain {
    static constexpr bool PERM = true, AFTER_DRAIN = false, MIDK = false;
    bf16_t* O; int ldo; float* part; int vt, vfull;
    __device__ __forceinline__ void operator()(AccRef acc, const Unit& u, int wr, int wc, int fr, int fq) const {
        if (part && (u.pm % vt) >= vfull) { const int v = u.pm / vt, rt = u.pm % vt - vfull, ks = u.kt0 / u.nt, nrest = (vt - vfull) * BM;
#pragma unroll
            for (int ai = 0; ai < 2; ++ai)
#pragma unroll
                for (int m = 0; m < 4; ++m) { float* pr = part + ((size_t)(ks * 4 + v) * 32 * nrest + rt * BM + ai * HALF + wr * 64 + m * 16 + fr) * 8;
#pragma unroll
                    for (int bj = 0; bj < 2; ++bj) { float* q = pr + (size_t)(bj * 16 + wc * 4 + fq) * nrest * 8; *(f32x4*)q = acc[ai][bj][m][0]; *(f32x4*)(q + 4) = acc[ai][bj][m][1]; } }
            return; }
#pragma unroll
        for (int ai = 0; ai < 2; ++ai)
#pragma unroll
            for (int m = 0; m < 4; ++m) { bf16_t* rowp = O + (size_t)EPI_ROW(ai, m) * ldo;
#pragma unroll
                for (int bj = 0; bj < 2; ++bj) *(u32x4*)(rowp + EPI_COL(bj)) = pack8(acc[ai][bj][m][0], acc[ai][bj][m][1]); }
    }
};
struct EpiSwiglu {
    static constexpr bool PERM = true, AFTER_DRAIN = false, MIDK = false;
    bf16_t* H; int ldo; const float* ssq;
    __device__ __forceinline__ void operator()(AccRef acc, const Unit& u, int wr, int wc, int fr, int fq) const {
        const int col = u.pn * HALF + wc * 32 + 8 * fq;
#pragma unroll
        for (int ai = 0; ai < 2; ++ai)
#pragma unroll
            for (int m = 0; m < 4; ++m) { const int row = EPI_ROW(ai, m); const float rs = rstd_of(ssq[row]);
                f32x4 h0, h1;
#pragma unroll
                for (int e = 0; e < 4; ++e) { h0[e] = siluf_(acc[ai][0][m][0][e] * rs) * (acc[ai][1][m][0][e] * rs); h1[e] = siluf_(acc[ai][0][m][1][e] * rs) * (acc[ai][1][m][1][e] * rs); }
                *(u32x4*)(H + (size_t)row * ldo + col) = pack8(h0, h1); asm volatile("" ::: "memory"); }
    }
};
struct EpiResid {
    static constexpr bool PERM = true, AFTER_DRAIN = false, MIDK = false;
    const float* baseP; const float* baseS; float* xr; bf16_t* xb; float* ssq_out; float scale; float* part; int mode;
    __device__ __forceinline__ void operator()(AccRef acc, const Unit& u, int wr, int wc, int fr, int fq) const {
        if (part && u.pm >= NP / BM) { const int ks = u.kt0 / u.nt;
#pragma unroll
            for (int ai = 0; ai < 2; ++ai)
#pragma unroll
                for (int m = 0; m < 4; ++m) { float* pr = part + ((size_t)ks * NSR + (EPI_ROW(ai, m) - NP)) * DM;
#pragma unroll
                    for (int bj = 0; bj < 2; ++bj) { const int col = EPI_COL(bj); *(f32x4*)(pr + col) = acc[ai][bj][m][0]; *(f32x4*)(pr + col + 4) = acc[ai][bj][m][1]; } }
            return; }
#pragma unroll
        for (int ai = 0; ai < 2; ++ai)
#pragma unroll
            for (int m = 0; m < 4; ++m) { const int row = EPI_ROW(ai, m);
                const float* bp = row < NP ? baseP + (size_t)row * DM : baseS + (size_t)(row - NP) * DM; float ss = 0.f;
#pragma unroll
                for (int bj = 0; bj < 2; ++bj) { const int col = EPI_COL(bj);
                    f32x4 o0, o1; if (mode & 1) unpack8(*(const u32x4*)(xb + (size_t)row * DM + col), o0, o1); else { o0 = *(const f32x4*)(bp + col); o1 = *(const f32x4*)(bp + col + 4); }
                    const f32x4 n0 = o0 + acc[ai][bj][m][0] * scale, n1 = o1 + acc[ai][bj][m][1] * scale;
                    if (!(mode & 2) || row >= NP) { *(f32x4*)(xr + (size_t)row * DM + col) = n0; *(f32x4*)(xr + (size_t)row * DM + col + 4) = n1; }
                    *(u32x4*)(xb + (size_t)row * DM + col) = pack8(n0, n1);
                    ss += (n0[0] * n0[0] + n0[1] * n0[1]) + (n0[2] * n0[2] + n0[3] * n0[3]) + (n1[0] * n1[0] + n1[1] * n1[1]) + (n1[2] * n1[2] + n1[3] * n1[3]); }
                ss += __shfl_xor(ss, 16); ss += __shfl_xor(ss, 32);
                if (fq == 0) atomicAdd(ssq_out + row, ss); asm volatile("" ::: "memory"); }
    }
};
struct EpiWin {
    static constexpr bool PERM = true, AFTER_DRAIN = false, MIDK = false;
    const float* ssq; float* out; bf16_t *Q, *CCBP, *KVS, *KVW, *U, *MG; float* NG;
    __device__ __forceinline__ void operator()(AccRef acc, const Unit& u, int wr, int wc, int fr, int fq) const {
        const int pn = u.pn;
#pragma unroll
        for (int ai = 0; ai < 2; ++ai)
#pragma unroll
            for (int m = 0; m < 4; ++m) { const int row = EPI_ROW(ai, m); const float rs = rstd_of(ssq[row]);
#pragma unroll
                for (int bj = 0; bj < 2; ++bj) { const int c = bj * HALF + wc * 32 + 8 * fq;
                    f32x4 v0 = acc[ai][bj][m][0] * rs, v1 = acc[ai][bj][m][1] * rs;
                    if (pn < 2) { v0 = v0 * (0.125f * LOG2E); v1 = v1 * (0.125f * LOG2E); *(u32x4*)(Q + (size_t)row * 512 + pn * 256 + c) = pack8(v0, v1); }
                    else if (pn < 5) {
                        float* op; bool wr_out = true;
                        if (row < NP) { const int t = row & (SEQ - 1), b = row >> 11;
                            if (pn == 2) op = out + O_KVCP + (size_t)row * 256; else if (pn == 3) op = out + O_KVSP + (size_t)row * 256;
                            else { op = out + O_KVWP + (size_t)(b * 512 + (t - 1536)) * 256; wr_out = t >= 1536; } }
                        else { const int sr = row - NP, b = sr >> 2, s = sr & 3;
                            if (pn == 2) op = out + O_KVCS + (size_t)sr * 256; else if (pn == 3) op = out + O_KVSS + (size_t)sr * 256;
                            else op = out + O_KVWS + (size_t)(b * 512 + 508 + s) * 256; }
                        if (wr_out) { *(f32x4*)(op + c) = v0; *(f32x4*)(op + c + 4) = v1; }
                        const u32x4 w = pack8(v0, v1);
                        if (pn == 2) { if (row < NP) *(u32x4*)(CCBP + (size_t)row * 256 + c) = w; }
                        else if (pn == 3) *(u32x4*)(KVS + (size_t)row * 256 + c) = w;
                        else *(u32x4*)(KVW + (size_t)row * 256 + c) = w; }
                    else if (pn < 7) { *(u32x4*)(U + (size_t)row * 512 + (pn - 5) * 256 + c) = pack8(v0, v1); }
                    else if (pn < 15) { if (bj == 0) {
                        f32x4 s0 = acc[ai][1][m][0] * rs, s1 = acc[ai][1][m][1] * rs;
#pragma unroll
                        for (int e = 0; e < 4; ++e) { s0[e] = fmaxf(sigmoidf_(s0[e]), 1e-30f); s1[e] = fmaxf(sigmoidf_(s1[e]), 1e-30f); v0[e] = sigmoidf_(v0[e]) * fast_rcp(s0[e]); v1[e] = sigmoidf_(v1[e]) * fast_rcp(s1[e]); }
                        const int cg = (pn - 7) * 128 + wc * 32 + 8 * fq;
                        *(u32x4*)(MG + (size_t)row * 2048 + cg) = pack8(v0, v1); *(u32x4*)(MG + (size_t)row * 2048 + 1024 + cg) = pack8(s0, s1); } }
                    else { if (c < 24) {
#pragma unroll
                        for (int e = 0; e < 4; ++e) { v0[e] = sigmoidf_(v0[e]); v1[e] = sigmoidf_(v1[e]); }
                        *(f32x4*)(NG + (size_t)row * 24 + c) = v0; *(f32x4*)(NG + (size_t)row * 24 + c + 4) = v1; } }
                } asm volatile("" ::: "memory"); }
    }
};
struct EpiGlu {
    static constexpr bool PERM = true, AFTER_DRAIN = false, MIDK = false;
    const bf16_t* YG; bf16_t* AO;
    __device__ __forceinline__ void operator()(AccRef acc, const Unit& u, int wr, int wc, int fr, int fq) const {
#pragma unroll
        for (int ai = 0; ai < 2; ++ai)
#pragma unroll
            for (int m = 0; m < 4; ++m) { const int row = EPI_ROW(ai, m);
#pragma unroll
                for (int bj = 0; bj < 2; ++bj) { const int col = EPI_COL(bj); f32x4 y0, y1; unpack8(*(const u32x4*)(YG + (size_t)row * 512 + col), y0, y1);
#pragma unroll
                    for (int e = 0; e < 4; ++e) { y0[e] *= sigmoidf_(acc[ai][bj][m][0][e]); y1[e] *= sigmoidf_(acc[ai][bj][m][1][e]); }
                    *(u32x4*)(AO + (size_t)row * DM + 512 + col) = pack8(y0, y1); } asm volatile("" ::: "memory"); }
    }
};
struct EpiMerge {
    static constexpr bool PERM = true, AFTER_DRAIN = false, MIDK = true;
    const bf16_t* MG; bf16_t* TT;
    __device__ __forceinline__ void mid(f32x4 (&acc)[2][2][4][2], const Unit& u, int wr, int wc, int fr, int fq) const {
#pragma unroll
        for (int ai = 0; ai < 2; ++ai)
#pragma unroll
            for (int m = 0; m < 4; ++m) { const int row = EPI_ROW(ai, m);
#pragma unroll
                for (int bj = 0; bj < 2; ++bj) { const int col = EPI_COL(bj); f32x4 a0, a1; unpack8(*(const u32x4*)(MG + (size_t)row * 2048 + col), a0, a1);
                    acc[ai][bj][m][0] = acc[ai][bj][m][0] * a0; acc[ai][bj][m][1] = acc[ai][bj][m][1] * a1; }
                asm volatile("" ::: "memory"); }
    }
    __device__ __forceinline__ void operator()(AccRef acc, const Unit& u, int wr, int wc, int fr, int fq) const {
#pragma unroll
        for (int ai = 0; ai < 2; ++ai)
#pragma unroll
            for (int m = 0; m < 4; ++m) { const int row = EPI_ROW(ai, m);
#pragma unroll
                for (int bj = 0; bj < 2; ++bj) { const int col = EPI_COL(bj); f32x4 s0, s1; unpack8(*(const u32x4*)(MG + (size_t)row * 2048 + 1024 + col), s0, s1);
                    *(u32x4*)(TT + (size_t)row * DM + col) = pack8(s0 * acc[ai][bj][m][0], s1 * acc[ai][bj][m][1]); }
                asm volatile("" ::: "memory"); }
    }
};
struct EpiMerge1 {
    static constexpr bool PERM = true, AFTER_DRAIN = false, MIDK = false;
    const bf16_t* MG; float* T1;
    __device__ __forceinline__ void operator()(AccRef acc, const Unit& u, int wr, int wc, int fr, int fq) const {
#pragma unroll
        for (int ai = 0; ai < 2; ++ai)
#pragma unroll
            for (int m = 0; m < 4; ++m) { const int row = EPI_ROW(ai, m);
#pragma unroll
                for (int bj = 0; bj < 2; ++bj) { const int col = EPI_COL(bj); f32x4 g0, g1; unpack8(*(const u32x4*)(MG + (size_t)row * 2048 + col), g0, g1);
                    *(f32x4*)(T1 + (size_t)row * DM + col) = g0 * acc[ai][bj][m][0]; *(f32x4*)(T1 + (size_t)row * DM + col + 4) = g1 * acc[ai][bj][m][1]; } asm volatile("" ::: "memory"); }
    }
};
struct EpiMerge2 {
    static constexpr bool PERM = true, AFTER_DRAIN = false, MIDK = false;
    const bf16_t* MG; const float* T1; bf16_t* TT;
    __device__ __forceinline__ void operator()(AccRef acc, const Unit& u, int wr, int wc, int fr, int fq) const {
#pragma unroll
        for (int ai = 0; ai < 2; ++ai)
#pragma unroll
            for (int m = 0; m < 4; ++m) { const int row = EPI_ROW(ai, m);
#pragma unroll
                for (int bj = 0; bj < 2; ++bj) { const int col = EPI_COL(bj); f32x4 g0, g1; unpack8(*(const u32x4*)(MG + (size_t)row * 2048 + 1024 + col), g0, g1);
                    const f32x4 t0 = *(const f32x4*)(T1 + (size_t)row * DM + col) + g0 * acc[ai][bj][m][0], t1 = *(const f32x4*)(T1 + (size_t)row * DM + col + 4) + g1 * acc[ai][bj][m][1];
                    *(u32x4*)(TT + (size_t)row * DM + col) = pack8(t0, t1); } asm volatile("" ::: "memory"); }
    }
};
struct EpiPleGate {
    static constexpr bool PERM = true, AFTER_DRAIN = false, MIDK = false;
    const float* ssq; const bf16_t* PP; float* xr; float* ssq_out; float* part; const bf16_t* xbase; bf16_t* xout;
    __device__ __forceinline__ void operator()(AccRef acc, const Unit& u, int wr, int wc, int fr, int fq) const {
        if (part && u.pm >= NP / BM) { const int ks = u.kt0 / u.nt;
#pragma unroll
            for (int ai = 0; ai < 2; ++ai)
#pragma unroll
                for (int m = 0; m < 4; ++m) { float* pr = part + ((size_t)ks * NSR + (EPI_ROW(ai, m) - NP)) * DM;
#pragma unroll
                    for (int bj = 0; bj < 2; ++bj) { const int col = EPI_COL(bj); *(f32x4*)(pr + col) = acc[ai][bj][m][0]; *(f32x4*)(pr + col + 4) = acc[ai][bj][m][1]; } }
            return; }
#pragma unroll
        for (int ai = 0; ai < 2; ++ai)
#pragma unroll
            for (int m = 0; m < 4; ++m) { const int row = EPI_ROW(ai, m); const float rs = rstd_of(ssq[row]); float ss = 0.f;
#pragma unroll
                for (int bj = 0; bj < 2; ++bj) { const int col = EPI_COL(bj); f32x4 p0, p1; unpack8(*(const u32x4*)(PP + (size_t)row * DM + col), p0, p1);
                    f32x4 n0, n1; unpack8(*(const u32x4*)(xbase + (size_t)row * DM + col), n0, n1);
#pragma unroll
                    for (int e = 0; e < 4; ++e) { n0[e] += sigmoidf_(acc[ai][bj][m][0][e] * rs) * p0[e]; n1[e] += sigmoidf_(acc[ai][bj][m][1][e] * rs) * p1[e]; }
                    *(u32x4*)(xout + (size_t)row * DM + col) = pack8(n0, n1);
                    ss += (n0[0] * n0[0] + n0[1] * n0[1]) + (n0[2] * n0[2] + n0[3] * n0[3]) + (n1[0] * n1[0] + n1[1] * n1[1]) + (n1[2] * n1[2] + n1[3] * n1[3]); }
                ss += __shfl_xor(ss, 16); ss += __shfl_xor(ss, 32);
                if (fq == 0) atomicAdd(ssq_out + row, ss); asm volatile("" ::: "memory"); }
    }
};
template <class Epi, class Sched, bool ALIGN_EPI = false, bool SP2 = false>
__device__ __forceinline__ void gemm_phase(PG8_LAS unsigned char* lds, const Gemm g, const Sched& S, const Epi& E) {
    const int tid = threadIdx.x, wid = __builtin_amdgcn_readfirstlane(tid >> 6), lane = tid & 63, wr = wid >> 2, wc = wid & 3, fr = lane & 15, fq = lane >> 4;
    const int K = g.K;
    unsigned voffA[2], voffB[2];
#pragma unroll
    for (int i = 0; i < 2; ++i) { int R, C; stage_rc(tid * 16 + i * 8192, R, C); const int Rb = Epi::PERM ? ((R & ~31) + perm32(R & 31)) : R;
        voffA[i] = (unsigned)(R * g.lda + C) * 2u; voffB[i] = (unsigned)(Rb * K + C) * 2u; }
    const size_t kstep = (size_t)(BK * 2), kstepA = (size_t)g.kstepA * 2;
    const size_t hstep = (size_t)HALF * K * 2, hstepA = (size_t)HALF * g.lda * 2;
        const unsigned ldsw = (unsigned)wid * 1024u;
    const int aoff = lds_byte(wr * 64 + fr, fq * 8), boff = lds_byte(wc * 32 + fr, fq * 8);
#define PG8_SA(b, h) (((b) * 2 + (h)) * HTB)
#define PG8_SB(b, h) ((4 + (b) * 2 + (h)) * HTB)
#define PG8_STAGE(bufoff, gbase, voff) do { _Pragma("unroll") for (int _i = 0; _i < 2; ++_i) \
        __builtin_amdgcn_global_load_lds((const unsigned*)((const char*)(gbase) + (voff)[_i]), (PG8_LAS unsigned*)(lds + (bufoff) + ldsw + _i * 8192), 16, 0, 0); } while (0)
#define PG8_LDA(dst, b, h) do { _Pragma("unroll") for (int m = 0; m < 4; ++m) _Pragma("unroll") for (int k = 0; k < 2; ++k) dst[m][k] = *(const PG8_LAS bf16x8*)(lds + PG8_SA(b, h) + aoff + m * 2048 + k * 1024); } while (0)
#define PG8_LDB(dst, b, h) do { _Pragma("unroll") for (int n = 0; n < 2; ++n) _Pragma("unroll") for (int k = 0; k < 2; ++k) dst[n][k] = *(const PG8_LAS bf16x8*)(lds + PG8_SB(b, h) + boff + n * 2048 + k * 1024); } while (0)
#define PG8_MMA(ai, bj, At, Bt) do { __builtin_amdgcn_s_setprio(1); _Pragma("unroll") for (int m = 0; m < 4; ++m) _Pragma("unroll") for (int n = 0; n < 2; ++n) _Pragma("unroll") for (int k = 0; k < 2; ++k) \
        acc[ai][bj][m][n] = __builtin_amdgcn_mfma_f32_16x16x32_bf16(Bt[n][k], At[m][k], acc[ai][bj][m][n], 0, 0, 0); __builtin_amdgcn_s_setprio(0); } while (0)
#define PG8_WAIT_V(n) asm volatile("s_waitcnt vmcnt(" #n ")" ::: "memory")
#define PG8_WAIT_L(n) asm volatile("s_waitcnt lgkmcnt(" #n ")" ::: "memory")
#define PG8_BAR __builtin_amdgcn_s_barrier()
#define PG8_SCHED __builtin_amdgcn_sched_barrier(0)
    Unit cur, nxt; int ui = 0;
    if (!S.next(0, cur)) return;
    f32x4 acc[2][2][4][2];
#pragma unroll
    for (int a = 0; a < 2; ++a)
#pragma unroll
        for (int b = 0; b < 2; ++b)
#pragma unroll
            for (int m = 0; m < 4; ++m)
#pragma unroll
                for (int n = 0; n < 2; ++n) acc[a][b][m][n] = (f32x4){0.f, 0.f, 0.f, 0.f};
    bf16x8 At[4][2], B0[2][2], B1[2][2];
    const char* cA = g.a_tile(cur); const char* cB = g.b_tile(cur);
    S.a_ready(cur);
    if constexpr (SP2) {
        PG8_STAGE(PG8_SB(0, 0), cB, voffB); PG8_STAGE(PG8_SB(0, 1), cB + hstep, voffB); PG8_STAGE(PG8_SA(0, 0), cA, voffA); PG8_STAGE(PG8_SA(0, 1), cA + hstepA, voffA);
        if (wr == 1) PG8_BAR;
        PG8_WAIT_V(2); PG8_BAR;
        PG8_STAGE(PG8_SB(1, 0), cB + kstep, voffB); PG8_STAGE(PG8_SA(1, 0), cA + kstepA, voffA); PG8_STAGE(PG8_SB(1, 1), cB + hstep + kstep, voffB);
        PG8_WAIT_V(6); PG8_BAR;
    } else {
        PG8_STAGE(PG8_SB(0, 0), cB, voffB); PG8_STAGE(PG8_SA(0, 0), cA, voffA); PG8_STAGE(PG8_SB(0, 1), cB + hstep, voffB); PG8_STAGE(PG8_SA(0, 1), cA + hstepA, voffA);
        if (wr == 1) PG8_BAR;
        PG8_WAIT_V(4); PG8_BAR;
        PG8_STAGE(PG8_SB(1, 0), cB + kstep, voffB); PG8_STAGE(PG8_SA(1, 0), cA + kstepA, voffA); PG8_STAGE(PG8_SB(1, 1), cB + hstep + kstep, voffB);
        PG8_WAIT_V(6); PG8_BAR;
    }
    for (;;) {
        const bool has_next = S.next(ui + 1, nxt);
        const char* nA = has_next ? g.a_tile(nxt) : cA; const char* nB = has_next ? g.b_tile(nxt) : cB;
        const int nt = cur.nt;
        for (int t = 0; t < nt; t += 2) {
            const bool last = (t == nt - 2);
            const char* a1 = cA + (size_t)(t + 1) * kstepA;
            const char* a2 = last ? nA : cA + (size_t)(t + 2) * kstepA; const char* b2 = last ? nB : cB + (size_t)(t + 2) * kstep;
            const char* a3 = a2 + kstepA; const char* b3 = b2 + kstep;
            if (last && has_next) S.a_ready(nxt);
            if constexpr (Epi::MIDK) { if (t == (nt >> 1)) E.mid(acc, cur, wr, wc, fr, fq); }
            if constexpr (SP2) {
            PG8_LDB(B0, 0, 0); PG8_LDB(B1, 0, 1); PG8_SCHED; PG8_LDA(At, 0, 0); PG8_STAGE(PG8_SA(1, 1), a1 + hstepA, voffA);
            PG8_WAIT_V(8); PG8_WAIT_L(0); PG8_BAR; PG8_MMA(0, 0, At, B0); PG8_MMA(0, 1, At, B1); PG8_BAR; PG8_SCHED;
            PG8_LDA(At, 0, 1); PG8_STAGE(PG8_SB(0, 0), b2, voffB); PG8_STAGE(PG8_SB(0, 1), b2 + hstep, voffB); PG8_STAGE(PG8_SA(0, 0), a2, voffA);
            PG8_WAIT_V(8); PG8_WAIT_L(0); PG8_BAR; PG8_MMA(1, 0, At, B0); PG8_MMA(1, 1, At, B1); PG8_BAR; PG8_SCHED;
            PG8_LDB(B0, 1, 0); PG8_LDB(B1, 1, 1); PG8_SCHED; PG8_LDA(At, 1, 0); PG8_STAGE(PG8_SA(0, 1), a2 + hstepA, voffA);
            PG8_WAIT_V(8); PG8_WAIT_L(0); PG8_BAR; PG8_MMA(0, 0, At, B0); PG8_MMA(0, 1, At, B1); PG8_BAR; PG8_SCHED;
            PG8_LDA(At, 1, 1); PG8_STAGE(PG8_SB(1, 0), b3, voffB); PG8_STAGE(PG8_SB(1, 1), b3 + hstep, voffB); PG8_STAGE(PG8_SA(1, 0), a3, voffA);
            PG8_WAIT_V(8); PG8_WAIT_L(0); PG8_BAR; PG8_MMA(1, 0, At, B0); PG8_MMA(1, 1, At, B1); PG8_BAR; PG8_SCHED;
            } else {
            PG8_LDB(B0, 0, 0); PG8_SCHED; PG8_LDA(At, 0, 0); PG8_STAGE(PG8_SA(1, 1), a1 + hstepA, voffA);
            PG8_WAIT_L(8); PG8_BAR; PG8_WAIT_L(0); PG8_MMA(0, 0, At, B0); PG8_BAR; PG8_SCHED;
            PG8_LDB(B1, 0, 1); PG8_STAGE(PG8_SB(0, 0), b2, voffB);
            PG8_BAR; PG8_WAIT_L(0); PG8_MMA(0, 1, At, B1); PG8_BAR;
            PG8_LDA(At, 0, 1); PG8_STAGE(PG8_SA(0, 0), a2, voffA);
            PG8_BAR; PG8_WAIT_L(0); PG8_MMA(1, 0, At, B0); PG8_BAR; PG8_SCHED;
            PG8_STAGE(PG8_SB(0, 1), b2 + hstep, voffB);
            PG8_WAIT_V(6); PG8_BAR; PG8_MMA(1, 1, At, B1); PG8_BAR;
            PG8_LDB(B0, 1, 0); PG8_SCHED; PG8_LDA(At, 1, 0); PG8_STAGE(PG8_SA(0, 1), a2 + hstepA, voffA);
            PG8_WAIT_L(8); PG8_BAR; PG8_WAIT_L(0); PG8_MMA(0, 0, At, B0); PG8_BAR; PG8_SCHED;
            PG8_LDB(B1, 1, 1); PG8_STAGE(PG8_SB(1, 0), b3, voffB);
            PG8_BAR; PG8_WAIT_L(0); PG8_MMA(0, 1, At, B1); PG8_BAR;
            PG8_LDA(At, 1, 1); PG8_STAGE(PG8_SA(1, 0), a3, voffA);
            PG8_BAR; PG8_WAIT_L(0); PG8_MMA(1, 0, At, B0); PG8_BAR; PG8_SCHED;
            PG8_STAGE(PG8_SB(1, 1), b3 + hstep, voffB);
            PG8_WAIT_V(6); PG8_BAR; PG8_MMA(1, 1, At, B1); PG8_BAR;
            }
        }
        if constexpr (ALIGN_EPI) { if (wr == 0) PG8_BAR; }
        if constexpr (!Epi::AFTER_DRAIN) { E(acc, cur, wr, wc, fr, fq); S.done(cur); }
        if (!has_next) break;
#pragma unroll
        for (int a = 0; a < 2; ++a)
#pragma unroll
            for (int b = 0; b < 2; ++b)
#pragma unroll
                for (int m = 0; m < 4; ++m)
#pragma unroll
                    for (int n = 0; n < 2; ++n) acc[a][b][m][n] = (f32x4){0.f, 0.f, 0.f, 0.f};
        cur = nxt; cA = nA; cB = nB; ++ui;
        if constexpr (ALIGN_EPI) { if (wr == 1) PG8_BAR; }
    }
    PG8_WAIT_V(0);
    if constexpr (!ALIGN_EPI) { if (wr == 0) PG8_BAR; }
    PG8_BAR;
    if constexpr (Epi::AFTER_DRAIN) { E.fused(acc, cur, wr, wc, fr, fq, lds, wid, lane); S.done(cur); }
#undef PG8_SA
#undef PG8_SB
#undef PG8_STAGE
#undef PG8_LDA
#undef PG8_LDB
#undef PG8_MMA
#undef PG8_WAIT_V
#undef PG8_WAIT_L
#undef PG8_BAR
#undef PG8_SCHED
}
}
struct Params {
    const float* in[45];
    float* out; unsigned char* ws;
    int ph_lo, ph_hi, coop, pad;
    unsigned char bucket[128];
};
enum InIdx { I_XP = 0, I_XS, I_CKC, I_CKS, I_SKW, I_SRE, I_SIM, I_PT, I_PP, I_PS, I_RELB, I_G1, I_W1G, I_W1U, I_W1D, I_GMIX, I_WIN, I_CPK, I_CW1K, I_CB1K, I_CW2K, I_CPV, I_CW1V, I_CB1V, I_CW2V,
             I_LRE, I_LIM, I_LDT, I_BRE, I_BIM, I_CRE, I_CIM, I_SD, I_WGLU, I_WBA, I_WBS, I_WOUT, I_G2, I_W2G, I_W2U, I_W2D, I_GPLE, I_WPG, I_WPP, I_GFIN };

struct Frame { LAS unsigned char* lds; int tid, lane, wave, G, vcu; };
__device__ __forceinline__ Frame launder(Frame F) { asm volatile("" : "+v"(F.tid)); F.lane = F.tid & 63; F.wave = __builtin_amdgcn_readfirstlane(F.tid >> 6); int g = F.G, v = F.vcu; asm volatile("" : "+s"(g), "+s"(v)); F.G = g; F.vcu = v; return F; }
__device__ __forceinline__ float wave_sum(float v) {
#pragma unroll
    for (int o = 1; o < 64; o <<= 1) v += __shfl_xor(v, o);
    return v;
}

__device__ __forceinline__ void transpose_item(const float* W, int N, bf16* WT, int KT, int k0, int drow0, int scol0, int nvalid, const float* gk, LAS float* scr, int lane) {
    { const int c4 = (lane & 7) * 4; f32x4 v[8];
#pragma unroll
      for (int i = 0; i < 8; ++i) { const int kk = 8 * i + (lane >> 3); v[i] = (f32x4){0.f, 0.f, 0.f, 0.f};
          if (c4 < nvalid) { v[i] = *(const f32x4*)(W + (size_t)(k0 + kk) * N + scol0 + c4); if (gk) v[i] = v[i] * gk[k0 + kk]; } }
#pragma unroll
      for (int i = 0; i < 8; ++i) { const int kk = 8 * i + (lane >> 3); LAS float* d = scr + kk * 33 + c4; d[0] = v[i][0]; d[1] = v[i][1]; d[2] = v[i][2]; d[3] = v[i][3]; } }
    LDS_WAIT();
    const int c8 = lane & 7;
#pragma unroll
    for (int j = 0; j < 4; ++j) { const int n = (lane >> 3) + 8 * j; const LAS float* s = scr + (8 * c8) * 33 + n;
        u32x4 o; o.x = pk2(s[0 * 33], s[1 * 33]); o.y = pk2(s[2 * 33], s[3 * 33]); o.z = pk2(s[4 * 33], s[5 * 33]); o.w = pk2(s[6 * 33], s[7 * 33]);
        *(u32x4*)(WT + (size_t)(drow0 + n) * KT + k0 + 8 * c8) = o; }
    LDS_WAIT();
}
__device__ __forceinline__ void row256_to_bf16(const float* src, bf16* dst, int lane) {
    const f32x4 v = *(const f32x4*)(src + 4 * lane); u32x2 w; w.x = pk2(v[0], v[1]); w.y = pk2(v[2], v[3]); *(u32x2*)(dst + 4 * lane) = w;
}

__device__ __forceinline__ void ssm_tables_item(const Params& P, LAS float* L, int item, int tid) {
    const int g = item >> 3, q = item & 7;
    LAS float* apw = L;
    LAS float* bbl = L + 33 * 128;
    LAS float* ccl = bbl + 2048;
    LAS float* krn = ccl + 2048;
    unsigned char* ws = P.ws;
    if (tid < 64) { const int p = tid;
        const float dt = expf(P.in[I_LDT][g]), lr = P.in[I_LRE][g * 64 + p], li = P.in[I_LIM][g * 64 + p];
        const float mag = expf(lr * dt), ang = li * dt, ar = mag * cosf(ang), ai = mag * sinf(ang);
        const float den = lr * lr + li * li, fr = ((ar - 1.0f) * lr + ai * li) / den, fi = (ai * lr - (ar - 1.0f) * li) / den;
        float pr = 1.f, pi = 0.f;
        for (int k = 0; k <= 32; ++k) { apw[(k * 64 + p) * 2] = pr; apw[(k * 64 + p) * 2 + 1] = pi; const float nr = pr * ar - pi * ai, ni = pr * ai + pi * ar; pr = nr; pi = ni; }
        f32x4 brv[4], biv[4];
#pragma unroll
        for (int c4 = 0; c4 < 4; ++c4) { brv[c4] = *(const f32x4*)(P.in[I_BRE] + (g * 64 + p) * 16 + 4 * c4); biv[c4] = *(const f32x4*)(P.in[I_BIM] + (g * 64 + p) * 16 + 4 * c4); }
#pragma unroll
        for (int c = 0; c < 16; ++c) { const float br = brv[c >> 2][c & 3], bi = biv[c >> 2][c & 3];
            const float xr = fr * br - fi * bi, xi = fr * bi + fi * br; bbl[(p * 16 + c) * 2] = xr; bbl[(p * 16 + c) * 2 + 1] = xi;
            if (q == 0) { ((float*)(ws + WS_BBT))[((g * 64 + p) * 16 + c) * 2] = xr; ((float*)(ws + WS_BBT))[((g * 64 + p) * 16 + c) * 2 + 1] = xi; } }
        if (q == 0) { ((float*)(ws + WS_ABT))[(g * 64 + p) * 2] = ar; ((float*)(ws + WS_ABT))[(g * 64 + p) * 2 + 1] = ai; }
    }
    for (int e = tid; e < 1024; e += NTHREADS) { const int c = e >> 6, p = e & 63; ccl[e * 2] = P.in[I_CRE][(g * 16 + c) * 64 + p]; ccl[e * 2 + 1] = P.in[I_CIM][(g * 16 + c) * 64 + p]; }
    __syncthreads();
    if (q == 0 && tid < 64) { ((float*)(ws + WS_ABL))[(g * 64 + tid) * 2] = apw[(32 * 64 + tid) * 2]; ((float*)(ws + WS_ABL))[(g * 64 + tid) * 2 + 1] = apw[(32 * 64 + tid) * 2 + 1]; }
    for (int o = tid; o < 1024; o += NTHREADS) { const int k = o >> 8, c = (o >> 4) & 15, c2 = o & 15, lag = q + 8 * k; float s = 0.f;
        for (int p = 0; p < 64; ++p) { const float ar = apw[(lag * 64 + p) * 2], ai = apw[(lag * 64 + p) * 2 + 1], br = bbl[(p * 16 + c2) * 2], bi = bbl[(p * 16 + c2) * 2 + 1];
            const float tr = ar * br - ai * bi, ti = ar * bi + ai * br; s += ccl[(c * 64 + p) * 2] * tr - ccl[(c * 64 + p) * 2 + 1] * ti; }
        krn[o] = s; }
    __syncthreads();
    bf16* TZ = (bf16*)(ws + WS_TZ) + (size_t)g * 512 * 512;
    for (int e = tid; e < 2048; e += NTHREADS) { const int k = e >> 9, j = (e >> 4) & 31, c = e & 15, lag = q + 8 * k;
        if (j >= lag) { const int i = j - lag; const LAS float* kp = krn + k * 256 + c * 16; u32x4 w0, w1;
            w0.x = pk2(kp[0], kp[1]); w0.y = pk2(kp[2], kp[3]); w0.z = pk2(kp[4], kp[5]); w0.w = pk2(kp[6], kp[7]); w1.x = pk2(kp[8], kp[9]); w1.y = pk2(kp[10], kp[11]); w1.z = pk2(kp[12], kp[13]); w1.w = pk2(kp[14], kp[15]);
            bf16* d = TZ + (size_t)(j * 16 + c) * 512 + i * 16; *(u32x4*)d = w0; *(u32x4*)(d + 8) = w1; } }
    { const int rr = tid >> 3, seg = tid & 7, j = q + 8 * (rr >> 4), c = rr & 15; bf16* d = TZ + (size_t)(j * 16 + c) * 512;
#pragma unroll
      for (int r4 = 0; r4 < 4; ++r4) { const int col = 64 * seg + 16 * r4; if (col >= (j + 1) * 16) { *(u32x4*)(d + col) = (u32x4){0u, 0u, 0u, 0u}; *(u32x4*)(d + col + 8) = (u32x4){0u, 0u, 0u, 0u}; } } }
    { const int n = 16 * q + (tid >> 5), i = tid & 31, p = n & 63, im = n >> 6; const float ar = apw[((31 - i) * 64 + p) * 2], ai = apw[((31 - i) * 64 + p) * 2 + 1]; float v[16];
#pragma unroll
      for (int c = 0; c < 16; ++c) { const float br = bbl[(p * 16 + c) * 2], bi = bbl[(p * 16 + c) * 2 + 1]; v[c] = im ? (ar * bi + ai * br) : (ar * br - ai * bi); }
      bf16* d = (bf16*)(ws + WS_PT) + ((size_t)g * 128 + n) * 512 + i * 16; u32x4 w0, w1;
      w0.x = pk2(v[0], v[1]); w0.y = pk2(v[2], v[3]); w0.z = pk2(v[4], v[5]); w0.w = pk2(v[6], v[7]); w1.x = pk2(v[8], v[9]); w1.y = pk2(v[10], v[11]); w1.z = pk2(v[12], v[13]); w1.w = pk2(v[14], v[15]);
      *(u32x4*)d = w0; *(u32x4*)(d + 8) = w1; }
    { const int row = 64 * q + (tid >> 3), n0 = (tid & 7) * 16, j = row >> 4, c = row & 15; float v[16];
#pragma unroll
      for (int e = 0; e < 16; ++e) { const int n = n0 + e, p = n & 63; const float ar = apw[((j + 1) * 64 + p) * 2], ai = apw[((j + 1) * 64 + p) * 2 + 1], cr = ccl[(c * 64 + p) * 2], ci = ccl[(c * 64 + p) * 2 + 1];
          v[e] = (n0 < 64) ? (cr * ar - ci * ai) : -(cr * ai + ci * ar); }
      bf16* d = (bf16*)(ws + WS_WC) + ((size_t)g * 512 + row) * 128 + n0; u32x4 w0, w1;
      w0.x = pk2(v[0], v[1]); w0.y = pk2(v[2], v[3]); w0.z = pk2(v[4], v[5]); w0.w = pk2(v[6], v[7]); w1.x = pk2(v[8], v[9]); w1.y = pk2(v[10], v[11]); w1.z = pk2(v[12], v[13]); w1.w = pk2(v[14], v[15]);
      *(u32x4*)d = w0; *(u32x4*)(d + 8) = w1; }
    __syncthreads();
}

__device__ __forceinline__ void transpose_jobs(const Params& P, unsigned jobmask, int gw, int NGW, LAS float* scr, int lane);
template <int PARTS> __device__ __forceinline__ void background_copy(const Params& P, int gw, int NGW, int lane, LAS float* scr) {
    unsigned char* ws = P.ws;
    if (PARTS & 3) transpose_jobs(P, ((PARTS & 1) ? 0x0038u : 0u) | ((PARTS & 2) ? 0x07C0u : 0u), gw, NGW, scr, lane);
    if (PARTS & 4) { bf16* PB = (bf16*)(ws + WS_PB);
      for (int m0 = gw * 4; m0 < MR; m0 += NGW * 4) { f32x4 v[4];
#pragma unroll
          for (int i = 0; i < 4; ++i) { const int m = m0 + i; v[i] = *(const f32x4*)((m < NP ? P.in[I_PP] + (size_t)m * PLE : P.in[I_PS] + (size_t)(m - NP) * PLE) + 4 * lane); }
#pragma unroll
          for (int i = 0; i < 4; ++i) { u32x2 w; w.x = pk2(v[i][0], v[i][1]); w.y = pk2(v[i][2], v[i][3]); *(u32x2*)(PB + (size_t)(m0 + i) * PLE + 4 * lane) = w; } } }
    if (PARTS & 8) { bf16* CCB = (bf16*)(ws + WS_CCB); const int* pt = (const int*)P.in[I_PT];
      for (int r0 = gw * 16; r0 < DB * PAST; r0 += NGW * 16) { const int b = r0 >> 11, pos0 = r0 & 2047; const int page = pt[b * 16 + (pos0 >> 7)];
          const float* src = P.in[I_CKC] + ((size_t)page * 128 + (pos0 & 127)) * 256 + 4 * lane; f32x4 v[16];
#pragma unroll
          for (int i = 0; i < 16; ++i) v[i] = __builtin_nontemporal_load((const f32x4*)(src + (size_t)i * 256));
#pragma unroll
          for (int i = 0; i < 16; ++i) { u32x2 w; w.x = pk2(v[i][0], v[i][1]); w.y = pk2(v[i][2], v[i][3]); *(u32x2*)(CCB + (size_t)(r0 + i) * 256 + 4 * lane) = w; } } }
    if (PARTS & 48) { float* o = P.out + O_KVWS; constexpr int RLO = (PARTS & 16) ? 0 : (DB / 2) * 508, RHI = (PARTS & 32) ? DB * 508 : (DB / 2) * 508;
      for (int r0 = RLO + gw * 4; r0 < RHI; r0 += NGW * 16) { f32x4 v[16];
#pragma unroll
          for (int q = 0; q < 4; ++q) { const int r = r0 + q * NGW * 4; if (r < RHI) { const int b = r / 508, i0 = r % 508;
#pragma unroll
              for (int i = 0; i < 4; ++i) v[q * 4 + i] = __builtin_nontemporal_load((const f32x4*)(P.in[I_SKW] + ((size_t)b * 512 + i0 + i + 4) * 256 + 4 * lane)); } }
#pragma unroll
          for (int q = 0; q < 4; ++q) { const int r = r0 + q * NGW * 4; if (r < RHI) { const int b = r / 508, i0 = r % 508;
#pragma unroll
              for (int i = 0; i < 4; ++i) *(f32x4*)(o + ((size_t)b * 512 + i0 + i) * 256 + 4 * lane) = v[q * 4 + i]; } } } }
}
struct TJob { int src; int K, N, ndest, kind, gk; size_t wt; int ktot; };
__constant__ const TJob g_jobs[13] = {
        {I_W1G, DM, FF, 2 * FF, 1, I_G1, WS_WGU1, DM}, {I_W1D, FF, DM, DM, 0, -1, WS_WD1, FF}, {I_WIN, DM, 3864, NIN, 2, I_GMIX, WS_WIN, DM}, {I_WGLU, 512, 512, 512, 0, -1, WS_WGLU, 512},
        {I_WBA, 512, DM, DM, 0, -1, WS_WBA, 1024}, {I_WBS, 512, DM, DM, 0, -1, WS_WBA + 1024, 1024}, {I_WOUT, DM, DM, DM, 0, -1, WS_WOUT, DM}, {I_W2G, DM, FF, 2 * FF, 1, I_G2, WS_WGU2, DM},
        {I_W2D, FF, DM, DM, 0, -1, WS_WD2, FF}, {I_WPG, DM, DM, DM, 0, I_GPLE, WS_WPG, DM}, {I_WPP, PLE, DM, DM, 0, -1, WS_WPP, PLE}, {I_CW1K, 1024, 128, 512, 3, -1, WS_WC1, 1024}, {I_CW2K, 128, 64, 128, 4, -1, WS_WC2, 128} };
__device__ __forceinline__ void transpose_job_item(const Params& P, const TJob& J, int it, LAS float* scr, int lane) {
    unsigned char* ws = P.ws; const int nnb = J.ndest / 32;
    const int kb = it / nnb, nb = it % nnb, k0 = 64 * kb, d0 = 32 * nb; const float* W = P.in[J.src]; int scol0 = d0, nvalid = 32, N = J.N; bf16* WT = (bf16*)(ws + J.wt);
    if (J.kind == 1) { const int tile = d0 >> 8, within = d0 & 255; if (within >= 128) W = P.in[J.src + 1]; scol0 = tile * 128 + (within & 127); }
    else if (J.kind == 2) { if (d0 < 1280) scol0 = d0; else if (d0 < 1792) scol0 = d0 + 24; else if (d0 < 3840) { const int tile = (d0 - 1792) >> 8, within = (d0 - 1792) & 255; scol0 = 1816 + (within >= 128 ? 1024 : 0) + tile * 128 + (within & 127); } else if (d0 == 3840) { scol0 = 1280; nvalid = 24; } else nvalid = 0; }
    else if (J.kind == 3) { const int type = d0 >> 8, within = d0 & 255; W = P.in[type ? I_CW1V : I_CW1K]; if (within >= 128) W += (size_t)1024 * 128; scol0 = within & 127; }
    else if (J.kind == 4) { const int type = d0 >> 6; W = P.in[type ? I_CW2V : I_CW2K]; scol0 = d0 & 63; }
    transpose_item(W, N, WT, J.ktot, k0, d0, scol0, nvalid, J.gk >= 0 ? P.in[J.gk] : nullptr, scr, lane);
}
__device__ __forceinline__ void transpose_jobs(const Params& P, unsigned jobmask, int gw, int NGW, LAS float* scr, int lane) {
    int base = 0;
#pragma unroll 1
    for (int jb = 0; jb < 13; ++jb) { if (!((jobmask >> jb) & 1u)) continue; const TJob J = g_jobs[jb]; const int nit = (J.K / 64) * (J.ndest / 32);
        for (int it = gw - base % NGW; it < nit; it += NGW) { if (it < 0) continue; transpose_job_item(P, J, it, scr, lane); }
        base += nit; }
}
__device__ __forceinline__ void prologue(const Params& P, const Frame& F) {
    unsigned char* ws = P.ws;
    LAS float* scr = (LAS float*)(F.lds + F.wave * 16384);
    const int gw = F.vcu * NWAVES + F.wave, NGW = F.G * NWAVES, lane = F.lane;
    transpose_jobs(P, 0x1807, gw, NGW, scr, lane);
    { bf16* XB = (bf16*)(ws + WS_XB); float* ssq0 = (float*)(ws + WS_SSQ0);
      for (int m0 = gw * 3; m0 < MR; m0 += NGW * 3) { f32x4 v[3][4];
#pragma unroll
          for (int i = 0; i < 3; ++i) { const int m = m0 + i; const float* xr = m < NP ? P.in[I_XP] + (size_t)m * DM : P.in[I_XS] + (size_t)(m - NP) * DM;
#pragma unroll
              for (int j = 0; j < 4; ++j) v[i][j] = *(const f32x4*)(xr + 256 * j + 4 * lane); }
#pragma unroll
          for (int i = 0; i < 3; ++i) { const int m = m0 + i; float s = 0.f;
#pragma unroll
              for (int j = 0; j < 4; ++j) { s += (v[i][j][0] * v[i][j][0] + v[i][j][1] * v[i][j][1]) + (v[i][j][2] * v[i][j][2] + v[i][j][3] * v[i][j][3]);
                  u32x2 w; w.x = pk2(v[i][j][0], v[i][j][1]); w.y = pk2(v[i][j][2], v[i][j][3]); *(u32x2*)(XB + (size_t)m * DM + 256 * j + 4 * lane) = w; }
              s = wave_sum(s); if (lane == 0) ssq0[m] = s; } } }
    { float* cc = (float*)(ws + WS_CCON);
      for (int it = gw; it < 128; it += NGW) { const int type = it >> 6, nh = (it >> 5) & 1, kc = it & 31, n = nh * 64 + lane; const float* pos = P.in[type ? I_CPV : I_CPK] + kc * 64; const float* w1 = P.in[type ? I_CW1V : I_CW1K] + (size_t)kc * 64 * 128 + n;
          float s = kc == 0 ? P.in[type ? I_CB1V : I_CB1K][n] : 0.f;
#pragma unroll 16
          for (int k = 0; k < 64; ++k) s += pos[k] * w1[(size_t)k * 128];
          atomicAdd(cc + type * 128 + n, s); } }
    if (blockIdx.x == 0) { float* bt = (float*)(ws + WS_BIAS);
      for (int e = F.tid; e < 8 * 136; e += NTHREADS) { const int h = e / 136, n = e % 136; const int bk = n < 128 ? (int)P.bucket[n] : 31; bt[e] = P.in[I_RELB][bk * 8 + h] * LOG2E; } }
}
namespace att {
constexpr int SLOTB = 8192;
constexpr int L_K = 0, L_V = 2 * SLOTB, L_WS = 4 * SLOTB, L_IMP = L_WS + 2048, L_SEL = L_IMP + 4 * 64 * 33 * 4, L_UNI = L_SEL + 512, L_BT = L_UNI + 16, L_RES = L_BT + 8 * 136 * 4, L_END = L_RES + 8 * 8192;
typedef short v4i16_t __attribute__((ext_vector_type(4)));
__device__ __forceinline__ int crow(int r, int hi) { return (r & 3) + 8 * (r >> 2) + 4 * hi; }
__device__ __forceinline__ void swap_halves(float v, float& r0, float& r1) { float a = v, b = v;
    asm volatile("s_nop 1\n\tv_permlane32_swap_b32 %0, %1\n\ts_nop 1" : "+v"(a), "+v"(b)); r0 = a; r1 = b; }
__device__ __forceinline__ float other_half(float v, int hi) { float r0, r1; swap_halves(v, r0, r1); return hi ? r0 : r1; }
__device__ __forceinline__ float max_halves(float v) { float r0, r1; swap_halves(v, r0, r1); return fmaxf(r0, r1); }
__device__ __forceinline__ float sum_halves(float v) { float r0, r1; swap_halves(v, r0, r1); return r0 + r1; }

__device__ __forceinline__ void qkt(f32x16& p0, f32x16& p1, const LAS char* Ks, const bf16x8* qr, int r32, int hi, float cinit = 0.f) {
    const LAS char* kb = Ks + hi * 1024 + r32 * 16;
#pragma unroll
    for (int r = 0; r < 16; ++r) { p0[r] = cinit; p1[r] = cinit; }
#pragma unroll
    for (int d0 = 0; d0 < 4; ++d0) { const bf16x8 b0 = *(const LAS bf16x8*)(kb + d0 * 2048), b1 = *(const LAS bf16x8*)(kb + d0 * 2048 + 512);
        p0 = __builtin_amdgcn_mfma_f32_32x32x16_bf16(b0, qr[d0], p0, 0, 0, 0); p1 = __builtin_amdgcn_mfma_f32_32x32x16_bf16(b1, qr[d0], p1, 0, 0, 0); }
}
__device__ __forceinline__ s16x4 vtr(const LAS char* p) { return __builtin_bit_cast(s16x4, __builtin_amdgcn_ds_read_tr16_b64_v4i16((LAS v4i16_t*)p)); }
__device__ __forceinline__ void pv(f32x16* o, const LAS char* Vs, const bf16x8* pa, int lane, int hi) {
    const LAS char* vp = Vs + ((lane >> 4) & 1) * 32 + (lane & 3) * 8 + (4 * hi + ((lane & 15) >> 2)) * 64;
#pragma unroll
    for (int d0 = 0; d0 < 2; ++d0)
#pragma unroll
        for (int ks = 0; ks < 4; ++ks) { const s16x4 lo = vtr(vp + d0 * 4096 + ks * 1024), hh = vtr(vp + d0 * 4096 + ks * 1024 + 512);
            const bf16x8 vf = (bf16x8){lo[0], lo[1], lo[2], lo[3], hh[0], hh[1], hh[2], hh[3]};
            o[d0] = __builtin_amdgcn_mfma_f32_32x32x16_bf16(pa[ks], vf, o[d0], 0, 0, 0); }
}
__device__ __forceinline__ void pack_p(bf16x8* pa, const f32x16& p0, const f32x16& p1) {
#pragma unroll
    for (int k = 0; k < 2; ++k) { u32x4 w, x;
        w.x = pk2(p0[8 * k], p0[8 * k + 1]); w.y = pk2(p0[8 * k + 2], p0[8 * k + 3]); w.z = pk2(p0[8 * k + 4], p0[8 * k + 5]); w.w = pk2(p0[8 * k + 6], p0[8 * k + 7]);
        x.x = pk2(p1[8 * k], p1[8 * k + 1]); x.y = pk2(p1[8 * k + 2], p1[8 * k + 3]); x.z = pk2(p1[8 * k + 4], p1[8 * k + 5]); x.w = pk2(p1[8 * k + 6], p1[8 * k + 7]);
        pa[k] = __builtin_bit_cast(bf16x8, w); pa[2 + k] = __builtin_bit_cast(bf16x8, x); }
}
template <bool NEAR> __device__ __forceinline__ void mask_bias(f32x16& p0, f32x16& p1, int tq, int kbase, int kstride, int maxdist, bool rowok, const LAS float* btl, float bfar, int hi) {
#pragma unroll
    for (int r = 0; r < 16; ++r) { const int kl = crow(r, hi); const int d0 = tq - (kbase + kl * kstride), d1 = d0 - 32 * kstride;
        const bool v0 = rowok && d0 >= 0 && d0 <= maxdist, v1 = rowok && d1 >= 0 && d1 <= maxdist;
        float b0 = bfar, b1 = bfar;
        if (NEAR) { b0 = btl[min(max(d0, 0), 128)]; b1 = btl[min(max(d1, 0), 128)]; }
        p0[r] = v0 ? p0[r] + b0 : -INFINITY; p1[r] = v1 ? p1[r] + b1 : -INFINITY; }
}
__device__ __forceinline__ float rowmax32(const f32x16& p0, const f32x16& p1) {
    float a = fmaxf(p0[0], p1[0]);
#pragma unroll
    for (int r = 1; r < 16; ++r) a = fmaxf(a, fmaxf(p0[r], p1[r]));
    return a;
}
__device__ __forceinline__ float max3f(float a, float b, float c) { float r; asm("v_max3_f32 %0, %1, %2, %3" : "=v"(r) : "v"(a), "v"(b), "v"(c)); return r; }
__device__ __forceinline__ void tile_step(const LAS char* Ks, const LAS char* Vs, const bf16x8* qr, f32x16* o, float& ref, float& l, LAS float* wsf,
                                          int tq, int kbase, int maxdist, bool rowok, bool near, bool allin, const LAS float* btl, float bfar, int lane) {
    const int r32 = lane & 31, hi = lane >> 5;
    f32x16 p0, p1; qkt(p0, p1, Ks, qr, r32, hi);
    if (!allin) mask_bias<true>(p0, p1, tq, kbase, 1, maxdist, rowok, btl, bfar, hi);
    if (__any(ref != 0.f)) {
#pragma unroll
        for (int r = 0; r < 16; ++r) { p0[r] -= ref; p1[r] -= ref; } }
    float a = max3f(p0[0], p0[1], p1[0]), b = max3f(p0[2], p0[3], p1[1]); a = max3f(a, p1[2], p1[3]);
#pragma unroll
    for (int r = 4; r < 16; r += 4) { a = max3f(a, p0[r], p0[r + 1]); b = max3f(b, p0[r + 2], p0[r + 3]); a = max3f(a, p1[r], p1[r + 1]); b = max3f(b, p1[r + 2], p1[r + 3]); }
    float rm = max_halves(fmaxf(a, b));
    if (allin && !rowok) rm = -INFINITY;
    if (__any(rm > 8.0f)) { const float dl = rm > 8.0f ? rm : 0.f; ref += dl; const float f = fast_exp2(-dl); l *= f;
#pragma unroll
        for (int r = 0; r < 16; ++r) { p0[r] -= dl; p1[r] -= dl; const float fr = __shfl(f, crow(r, hi)); o[0][r] *= fr; o[1][r] *= fr; } }
    float s = 0.f;
#pragma unroll
    for (int r = 0; r < 16; ++r) { p0[r] = fast_exp2(p0[r]); p1[r] = fast_exp2(p1[r]); s += p0[r] + p1[r]; }
    if (allin && !__all(rowok)) { const float okf = rowok ? 1.f : 0.f; s *= okf;
#pragma unroll
        for (int r = 0; r < 16; ++r) { p0[r] *= okf; p1[r] *= okf; } }
    l += s;
    bf16x8 pa[4]; pack_p(pa, p0, p1);
    pv(o, Vs, pa, lane, hi);
}
template <bool FIRST> __device__ __forceinline__ void add_scaled(LAS float* resl, const f32x16* o, float fac, LAS float* wsf, int lane, int r32, int hi) {
#pragma unroll
    for (int r = 0; r < 16; ++r) { const float fr = __shfl(fac, crow(r, hi));
        if (FIRST) { resl[r * 64 + lane] = o[0][r] * fr; resl[(16 + r) * 64 + lane] = o[1][r] * fr; }
        else { resl[r * 64 + lane] += o[0][r] * fr; resl[(16 + r) * 64 + lane] += o[1][r] * fr; } }
    LDS_WAIT();
}
__device__ __forceinline__ u32x4 load8(const void* p, int kind) {
    if (kind == 1) return *(const u32x4*)p;
    if (kind == 2) { const f32x4 a = ((const f32x4*)p)[0], b = ((const f32x4*)p)[1]; u32x4 w; w.x = pk2(a[0], a[1]); w.y = pk2(a[2], a[3]); w.z = pk2(b[0], b[1]); w.w = pk2(b[2], b[3]); return w; }
    return (u32x4){0u, 0u, 0u, 0u};
}

template <bool SAMPLE> __device__ __forceinline__ void attn_unit(const Params& P, const Frame& F, int b, int hkv, int qt) {
    unsigned char* ws = P.ws;
    LAS char* lds = (LAS char*)F.lds;
    const int tid = F.tid, lane = F.lane, wave = F.wave, r32 = lane & 31, hi = lane >> 5, g = wave & 3, half = wave >> 2, head = hkv * 4 + g;
    const bf16* Qb = (const bf16*)(ws + WS_Q); const bf16* KVS = (const bf16*)(ws + WS_KVS); const bf16* KVW = (const bf16*)(ws + WS_KVW);
    const float* NG = (const float*)(ws + WS_NG);
    int tok, tq, qrow; bool tvalid;
    if (SAMPLE) { tok = r32 < 3 ? r32 : 3; tvalid = (r32 < 4) && (half == 0); tq = PAST + tok; qrow = NP + b * DS + tok; }
    else { tok = 32 * half + r32; tvalid = true; tq = 64 * qt + tok; qrow = b * SEQ + tq; }
    const int ba = SAMPLE ? b : DB + b, bt = SAMPLE ? 32 : qt, tqmin = SAMPLE ? PAST : 64 * qt + 32 * half, tqmax = SAMPLE ? PAST + DS - 1 : tqmin + 31;
    bf16x8 qr[4];
#pragma unroll
    for (int d0 = 0; d0 < 4; ++d0) qr[d0] = *(const bf16x8*)(Qb + (size_t)qrow * 512 + head * 64 + hi * 8 + d0 * 16);
    float gate_c = NG[(size_t)qrow * 24 + head * 3 + 0], gate_s = NG[(size_t)qrow * 24 + head * 3 + 1], gate_w = NG[(size_t)qrow * 24 + head * 3 + 2];
    LAS float* wsf = (LAS float*)(lds + L_WS) + wave * 64;
    const LAS float* btl = (const LAS float*)(lds + L_BT) + head * 136;
    const float bfar = btl[128];
    LAS float* resl = (LAS float*)(lds + L_RES) + wave * 2048;
    const int kkey = tid >> 3, kchunk = tid & 7;
    const int vkey = kkey, vd = kchunk * 8;
    const int kdst = kchunk * 1024 + kkey * 16, vdst = ((kchunk >> 2) * 4 + (kkey >> 4)) * 1024 + (kkey & 15) * 64 + (kchunk & 3) * 16;

    __syncthreads();
    { const bf16* KCb = (const bf16*)(ws + WS_KC) + (size_t)(ba * 2 + hkv) * 128 * 64; const bf16* VCb = (const bf16*)(ws + WS_VC) + (size_t)(ba * 2 + hkv) * 128 * 64;
#pragma unroll
      for (int jt = 0; jt < 2; ++jt) { *(LAS u32x4*)(lds + L_K + jt * SLOTB + kdst) = *(const u32x4*)(KCb + (size_t)(64 * jt + kkey) * 64 + kchunk * 8);
          *(LAS u32x4*)(lds + L_V + jt * SLOTB + vdst) = *(const u32x4*)(VCb + (size_t)(64 * jt + vkey) * 64 + vd); } }
    __syncthreads();
    {
        float m = -INFINITY, l = 0.f;
#pragma unroll 1
        for (int jt = 0; jt < 2; ++jt) { f32x16 a0, a1; qkt(a0, a1, lds + L_K + jt * SLOTB, qr, r32, hi);
            mask_bias<true>(a0, a1, tq, 31 + 1024 * jt, 16, 1 << 30, tvalid, btl, bfar, hi);
            const float rm = max_halves(rowmax32(a0, a1)), mnew = fmaxf(m, rm), ms = (mnew == -INFINITY) ? 0.f : mnew; float s = 0.f;
#pragma unroll
            for (int r = 0; r < 16; ++r) s += fast_exp2(a0[r] - ms) + fast_exp2(a1[r] - ms);
            l = l * fast_exp2(m - ms) + s; m = mnew; }
        const float L = sum_halves(l), inv = L > 0.f ? 1.0f / L : 0.f, ms = (m == -INFINITY) ? 0.f : m;
        LAS float* impw = (LAS float*)(lds + L_IMP) + (g * 64 + tok) * 33;
        float eprev = 0.f;
        f32x16 o[2]; o[0] = (f32x16){}; o[1] = (f32x16){};
#pragma unroll 1
        for (int jt = 0; jt < 2; ++jt) { f32x16 a0, a1; qkt(a0, a1, lds + L_K + jt * SLOTB, qr, r32, hi);
            mask_bias<true>(a0, a1, tq, 31 + 1024 * jt, 16, 1 << 30, tvalid, btl, bfar, hi);
#pragma unroll
            for (int r = 0; r < 16; ++r) { a0[r] = fast_exp2(a0[r] - ms) * inv; a1[r] = fast_exp2(a1[r] - ms) * inv; }
#pragma unroll
            for (int n = 0; n < 8; ++n) { const int a = n & 3, c = n >> 2;
                const f32x16& pp = c ? a1 : a0;
                const float G = (pp[4 * a] + pp[4 * a + 1]) + (pp[4 * a + 2] + pp[4 * a + 3]), E = pp[4 * a + 3];
                const float eo = other_half(E, hi);
                const float imp = G + (hi ? eo : eprev);
                eprev = eo;
                if (tvalid) impw[2 * (n + 8 * jt) + hi] = imp; }
            bf16x8 pa[4]; pack_p(pa, a0, a1); pv(o, lds + L_V + jt * SLOTB, pa, lane, hi); }
        add_scaled<true>(resl, o, gate_c, wsf, lane, r32, hi);
    }
    __syncthreads();
    if (tid < 64) {
        unsigned long long mask = 0ull;
        if (!SAMPLE || tid < 4) {
            LAS float* sc = (LAS float*)(lds + L_IMP) + tid * 33;
            for (int s = 0; s < 32; ++s) sc[s] = (sc[s] + sc[64 * 33 + s]) + (sc[2 * 64 * 33 + s] + sc[3 * 64 * 33 + s]);
            mask = 1ull | (1ull << bt); if (bt >= 1) mask |= 1ull << (bt - 1);
            const int picks = 8 - __popcll(mask);
            for (int it = 0; it < picks; ++it) { int best = -1; float bv = -1.0f;
                for (int s = 1; s <= bt - 2; ++s) { const float v = sc[s]; if (!((mask >> s) & 1ull) && v > bv) { bv = v; best = s; } }
                if (best >= 0) mask |= 1ull << best; }
        }
        ((LAS unsigned*)(lds + L_SEL))[2 * tid] = (unsigned)mask; ((LAS unsigned*)(lds + L_SEL))[2 * tid + 1] = (unsigned)(mask >> 32);
        unsigned ulo = (unsigned)mask, uhi = (unsigned)(mask >> 32);
#pragma unroll
        for (int o = 1; o < 64; o <<= 1) { ulo |= __shfl_xor(ulo, o); uhi |= __shfl_xor(uhi, o); }
        if (tid == 0) { ((LAS unsigned*)(lds + L_UNI))[0] = ulo; ((LAS unsigned*)(lds + L_UNI))[1] = uhi; }
    }
    __syncthreads();
    const unsigned long long mysel = (unsigned long long)((LAS unsigned*)(lds + L_SEL))[2 * tok] | ((unsigned long long)((LAS unsigned*)(lds + L_SEL))[2 * tok + 1] << 32);
    unsigned long long U = (unsigned long long)((LAS unsigned*)(lds + L_UNI))[0] | ((unsigned long long)((LAS unsigned*)(lds + L_UNI))[1] << 32);

    const int* ptab = (const int*)P.in[I_PT] + b * 16;
#define ATT_LOAD(br, j, rk, rv) do { \
        const void* pk_ = nullptr; const void* pv_ = nullptr; int kk_ = 0, kv_ = 0; \
        if (!SAMPLE) { const bf16* src_ = (br) == 1 ? KVS : KVW; \
            pk_ = src_ + (size_t)(b * SEQ + 64 * (j) + kkey) * 256 + hkv * 64 + kchunk * 8; pv_ = src_ + (size_t)(b * SEQ + 64 * (j) + vkey) * 256 + 128 + hkv * 64 + vd; kk_ = 1; kv_ = 1; } \
        else if ((br) == 1) { const int pk0 = 64 * (j) + kkey, pv0 = 64 * (j) + vkey; \
            if (pk0 < PAST) { pk_ = P.in[I_CKS] + ((size_t)ptab[pk0 >> 7] * 128 + (pk0 & 127)) * 256 + hkv * 64 + kchunk * 8; kk_ = 2; } \
            else if (pk0 < PAST + DS) { pk_ = KVS + (size_t)(NP + b * DS + pk0 - PAST) * 256 + hkv * 64 + kchunk * 8; kk_ = 1; } \
            if (pv0 < PAST) { pv_ = P.in[I_CKS] + ((size_t)ptab[pv0 >> 7] * 128 + (pv0 & 127)) * 256 + 128 + hkv * 64 + vd; kv_ = 2; } \
            else if (pv0 < PAST + DS) { pv_ = KVS + (size_t)(NP + b * DS + pv0 - PAST) * 256 + 128 + hkv * 64 + vd; kv_ = 1; } } \
        else { const int wk0 = 64 * (j) + kkey, wv0 = 64 * (j) + vkey; \
            if (wk0 < 512) { pk_ = P.in[I_SKW] + ((size_t)b * 512 + wk0) * 256 + hkv * 64 + kchunk * 8; kk_ = 2; } \
            else if (wk0 < 512 + DS) { pk_ = KVW + (size_t)(NP + b * DS + wk0 - 512) * 256 + hkv * 64 + kchunk * 8; kk_ = 1; } \
            if (wv0 < 512) { pv_ = P.in[I_SKW] + ((size_t)b * 512 + wv0) * 256 + 128 + hkv * 64 + vd; kv_ = 2; } \
            else if (wv0 < 512 + DS) { pv_ = KVW + (size_t)(NP + b * DS + wv0 - 512) * 256 + 128 + hkv * 64 + vd; kv_ = 1; } } \
        rk = load8(pk_, kk_); rv = load8(pv_, kv_); } while (0)

    {
        f32x16 o[2]; o[0] = (f32x16){}; o[1] = (f32x16){}; float m = 0.f, l = 0.f;
        u32x4 rk, rv; int idx = 0;
        { const int j0 = __builtin_ctzll(U); ATT_LOAD(1, j0, rk, rv); }
        while (U) { const int j = __builtin_ctzll(U); U &= U - 1ull;
            const int sl = (idx & 1) * SLOTB;
            *(LAS u32x4*)(lds + L_K + sl + kdst) = rk; *(LAS u32x4*)(lds + L_V + sl + vdst) = rv;
            __syncthreads();
            if (U) { const int jn = __builtin_ctzll(U); ATT_LOAD(1, jn, rk, rv); }
            const bool rowok = tvalid && ((mysel >> j) & 1ull);
            if (__any(rowok)) { const bool near = (tqmin - (64 * j + 63)) < 128;
                tile_step(lds + L_K + sl, lds + L_V + sl, qr, o, m, l, wsf, tq, 64 * j, 1 << 30, rowok, near, !near, btl, bfar, lane); }
            ++idx; }
        const float L = sum_halves(l);
        add_scaled<false>(resl, o, L > 0.f ? gate_s / L : 0.f, wsf, lane, r32, hi);
    }
    __syncthreads();
    {
        f32x16 o[2]; o[0] = (f32x16){}; o[1] = (f32x16){}; float m = 0.f, l = 0.f;
        const int jlo = SAMPLE ? 0 : (qt >= 8 ? qt - 8 : 0), jhi = SAMPLE ? 8 : qt, kb0 = SAMPLE ? PAST - 512 : 0;
        u32x4 rk, rv; int idx = 0;
        ATT_LOAD(2, jlo, rk, rv);
        for (int j = jlo; j <= jhi; ++j) {
            const int sl = (idx & 1) * SLOTB;
            *(LAS u32x4*)(lds + L_K + sl + kdst) = rk; *(LAS u32x4*)(lds + L_V + sl + vdst) = rv;
            __syncthreads();
            if (j < jhi) { ATT_LOAD(2, j + 1, rk, rv); }
            const int kbase = kb0 + 64 * j; const bool near = (tqmin - (kbase + 63)) < 128;
            const bool allin = !near && (tqmax - kbase) <= 512;
            if (!SAMPLE || half == 0) tile_step(lds + L_K + sl, lds + L_V + sl, qr, o, m, l, wsf, tq, kbase, 512, tvalid, near, allin, btl, bfar, lane);
            ++idx; }
        const float L = sum_halves(l);
        add_scaled<false>(resl, o, L > 0.f ? gate_w / L : 0.f, wsf, lane, r32, hi);
    }
#undef ATT_LOAD
    bf16* AO = (bf16*)(ws + WS_AO);
#pragma unroll
    for (int r = 0; r < 16; ++r) { const int q = crow(r, hi);
        if (SAMPLE) { if (half == 0 && q < 4) { bf16* op = AO + (size_t)(NP + b * DS + q) * DM + head * 64 + r32; op[0] = (bf16)f2bf(resl[r * 64 + lane]); op[32] = (bf16)f2bf(resl[(16 + r) * 64 + lane]); } }
        else { bf16* op = AO + (size_t)(b * SEQ + 64 * qt + 32 * half + q) * DM + head * 64 + r32; op[0] = (bf16)f2bf(resl[r * 64 + lane]); op[32] = (bf16)f2bf(resl[(16 + r) * 64 + lane]); } }
}

__device__ __forceinline__ void attn_phase(const Params& P, const Frame& F) {
    { const float* bt = (const float*)(P.ws + WS_BIAS); LAS float* d = (LAS float*)(F.lds + L_BT); for (int e = F.tid; e < 8 * 136; e += NTHREADS) d[e] = bt[e] - bt[(e / 136) * 136 + 128]; }
    __syncthreads();
    unsigned* ctr = (unsigned*)(P.ws + WS_CTL + 2048);
    volatile LAS unsigned* slot = (volatile LAS unsigned*)(F.lds + L_UNI) + 2;
#pragma unroll 1
    for (;;) {
        if (F.tid == 0) *slot = __hip_atomic_fetch_add(ctr, 1u, __ATOMIC_RELAXED, __HIP_MEMORY_SCOPE_AGENT);
        __syncthreads();
        const unsigned u = *slot;
        __syncthreads();
        if (u >= 768u) break;
        const bool smp = u < 512u && !(u & 1u); const unsigned w = u < 512u ? (u >> 1) : u - 256u;
        if (smp) { const Frame Fu = launder(F); attn_unit<true>(P, Fu, (int)(w >> 1), (int)(w & 1u), 0); }
        else { const int qt = 31 - (int)(w >> 4), bh = (int)(w & 15u); const Frame Fu = launder(F); attn_unit<false>(P, Fu, bh >> 1, bh & 1, qt); }
    }
    __syncthreads();
}
}
namespace ssm {
constexpr int L_SLOC = 0  , L_SPREV = 32768  , L_U = 51200  , L_END = L_U + 64 * 1040;
__device__ __forceinline__ void prompt_unit(const Params& P, const Frame& F, int b, int g) {
    unsigned char* ws = P.ws; LAS char* lds = (LAS char*)F.lds;
    const int tid = F.tid, lane = F.lane, wave = F.wave, r32 = lane & 31, hi = lane >> 5;
    const bf16* U = (const bf16*)(ws + WS_U); const bf16* PT = (const bf16*)(ws + WS_PT) + (size_t)g * 128 * 512;
    const bf16* TZ = (const bf16*)(ws + WS_TZ) + (size_t)g * 512 * 512; const bf16* WC = (const bf16*)(ws + WS_WC) + (size_t)g * 512 * 128;
    LAS float* sloc = (LAS float*)(lds + L_SLOC); LAS bf16* sprev = (LAS bf16*)(lds + L_SPREV); LAS char* ul = lds + L_U;
    const int mt = wave & 1;
    __syncthreads();
    {
#pragma unroll
      for (int i = 0; i < 8; ++i) { const int p = tid + NTHREADS * i, t = p >> 1, h = p & 1;
          *(LAS u32x4*)(ul + (t >> 5) * 1040 + (t & 31) * 32 + h * 16) = *(const u32x4*)(U + (size_t)(b * SEQ + t) * 512 + g * 16 + 8 * h); } }
    __syncthreads();
    const LAS char* arow = ul + (32 * mt + r32) * 1040 + hi * 16;
    { const int nt = wave >> 1; f32x16 acc = (f32x16){}; const bf16* brow = PT + (size_t)(32 * nt + r32) * 512 + 8 * hi;
#pragma unroll 8
      for (int ks = 0; ks < 32; ++ks) { const bf16x8 a = *(const LAS bf16x8*)(arow + ks * 32), bb = *(const bf16x8*)(brow + ks * 16);
          acc = __builtin_amdgcn_mfma_f32_32x32x16_bf16(a, bb, acc, 0, 0, 0); }
#pragma unroll
      for (int r = 0; r < 16; ++r) sloc[(32 * mt + att::crow(r, hi)) * 128 + 32 * nt + r32] = acc[r]; }
    __syncthreads();
    if (tid < 64) { const int p = tid; const float* abl = (const float*)(ws + WS_ABL) + (g * 64 + p) * 2; const float ar = abl[0], ai = abl[1]; float sr = 0.f, si = 0.f;
        for (int k = 0; k < 64; ++k) { sprev[k * 136 + p] = (bf16)f2bf(sr); sprev[k * 136 + 64 + p] = (bf16)f2bf(si);
            const float lr = sloc[k * 128 + p], li = sloc[k * 128 + 64 + p]; const float nr = ar * sr - ai * si + lr, ni = ar * si + ai * sr + li; sr = nr; si = ni; }
        P.out[O_SREP + (size_t)(b * 32 + g) * 64 + p] = sr; P.out[O_SIMP + (size_t)(b * 32 + g) * 64 + p] = si; }
    __syncthreads();
    { const int nq = wave >> 1; f32x16 acc[4];
#pragma unroll
      for (int e = 0; e < 4; ++e) acc[e] = (f32x16){};
#pragma unroll 4
      for (int ks = 0; ks < 32; ++ks) { const bf16x8 a = *(const LAS bf16x8*)(arow + ks * 32);
#pragma unroll
          for (int e = 0; e < 4; ++e) { const int nt = nq * 4 + e; if (2 * nt + 1 >= ks) { const bf16x8 bb = *(const bf16x8*)(TZ + (size_t)(32 * nt + r32) * 512 + ks * 16 + 8 * hi);
              acc[e] = __builtin_amdgcn_mfma_f32_32x32x16_bf16(a, bb, acc[e], 0, 0, 0); } } }
#pragma unroll
      for (int ks = 0; ks < 8; ++ks) { const bf16x8 a = *(const LAS bf16x8*)(sprev + (32 * mt + r32) * 136 + ks * 16 + 8 * hi);
#pragma unroll
          for (int e = 0; e < 4; ++e) { const int nt = nq * 4 + e; const bf16x8 bb = *(const bf16x8*)(WC + (size_t)(32 * nt + r32) * 128 + ks * 16 + 8 * hi);
              acc[e] = __builtin_amdgcn_mfma_f32_32x32x16_bf16(a, bb, acc[e], 0, 0, 0); } }
      bf16* YG = (bf16*)(ws + WS_YG);
#pragma unroll
      for (int e = 0; e < 4; ++e) { const int n = 32 * (nq * 4 + e) + r32, j = n >> 4, c = n & 15, ch = g * 16 + c; const float dsk = P.in[I_SD][ch];
#pragma unroll
          for (int r = 0; r < 16; ++r) { const int chunk = 32 * mt + att::crow(r, hi); const size_t row = (size_t)b * SEQ + chunk * 32 + j;
              const float y = acc[e][r] + dsk * bf2f(*(const LAS bf16*)(ul + chunk * 1040 + j * 32 + c * 2)); YG[row * 512 + ch] = (bf16)f2bf(gelu_tanh(y)); } } }
}
__device__ __forceinline__ void sample_wave(const Params& P, const Frame& F, int gw, int NGW, LAS float* sw  , LAS float* cw  ) {
    unsigned char* ws = P.ws; const int lane = F.lane, p = lane, t = lane >> 4, c = lane & 15;
    const bool gconst = (NGW & 31) == 0; int gcur = -1;
    float ar = 0.f, ai = 0.f, br[16], bi[16], dsk = 0.f;
#pragma unroll
    for (int i = 0; i < 16; ++i) { br[i] = 0.f; bi[i] = 0.f; }
#pragma unroll 1
    for (int pr = gw; pr < DB * 32; pr += NGW) { const int b = pr >> 5, g = pr & 31;
        if (g != gcur) { gcur = g;
            const float* abt = (const float*)(ws + WS_ABT) + (g * 64 + p) * 2; ar = abt[0]; ai = abt[1];
            const float* bbt = (const float*)(ws + WS_BBT) + (size_t)(g * 64 + p) * 32;
#pragma unroll
            for (int c4 = 0; c4 < 8; ++c4) { const f32x4 v = *(const f32x4*)(bbt + 4 * c4); br[2 * c4] = v[0]; bi[2 * c4] = v[1]; br[2 * c4 + 1] = v[2]; bi[2 * c4 + 1] = v[3]; }
            LDS_WAIT();
#pragma unroll
            for (int cc = 0; cc < 16; ++cc) { cw[cc * 65 + p] = P.in[I_CRE][(size_t)(g * 16 + cc) * 64 + p]; cw[1040 + cc * 65 + p] = P.in[I_CIM][(size_t)(g * 16 + cc) * 64 + p]; }
            dsk = P.in[I_SD][g * 16 + c]; LDS_WAIT(); (void)gconst; }
        const bf16* U = (const bf16*)(ws + WS_U) + (size_t)(NP + b * DS) * 512 + g * 16;
        float sr = P.in[I_SRE][(size_t)(b * 32 + g) * 64 + p], si = P.in[I_SIM][(size_t)(b * 32 + g) * 64 + p];
#pragma unroll
        for (int tt = 0; tt < DS; ++tt) { const u32x4 u0 = *(const u32x4*)(U + (size_t)tt * 512), u1 = *(const u32x4*)(U + (size_t)tt * 512 + 8);
            const float uu[16] = {bflo(u0.x), bfhi(u0.x), bflo(u0.y), bfhi(u0.y), bflo(u0.z), bfhi(u0.z), bflo(u0.w), bfhi(u0.w), bflo(u1.x), bfhi(u1.x), bflo(u1.y), bfhi(u1.y), bflo(u1.z), bfhi(u1.z), bflo(u1.w), bfhi(u1.w)};
            float xr = ar * sr - ai * si, xi = ar * si + ai * sr;
#pragma unroll
            for (int cc = 0; cc < 16; ++cc) { xr += br[cc] * uu[cc]; xi += bi[cc] * uu[cc]; }
            sr = xr; si = xi; sw[(tt * 64 + p) * 2] = sr; sw[(tt * 64 + p) * 2 + 1] = si; }
        P.out[O_SRES + (size_t)(b * 32 + g) * 64 + p] = sr; P.out[O_SIMS + (size_t)(b * 32 + g) * 64 + p] = si;
        LDS_WAIT();
        float y = 0.f;
#pragma unroll 8
        for (int pp = 0; pp < 64; ++pp) y += cw[c * 65 + pp] * sw[(t * 64 + pp) * 2] - cw[1040 + c * 65 + pp] * sw[(t * 64 + pp) * 2 + 1];
        const size_t row = (size_t)NP + b * DS + t; const int ch = g * 16 + c; const float uv = bf2f(((const bf16*)(ws + WS_U))[row * 512 + ch]);
        y = gelu_tanh(y + dsk * uv); ((bf16*)(ws + WS_YG))[row * 512 + ch] = (bf16)f2bf(y);
        LDS_WAIT(); }
}
}

constexpr int SPLIT_C = 4;
__device__ __forceinline__ u32x4 gelu_pack(f32x4 x0, f32x4 x1) { u32x4 w; w.x = pk2(gelu_tanh(x0[0]), gelu_tanh(x0[1])); w.y = pk2(gelu_tanh(x0[2]), gelu_tanh(x0[3])); w.z = pk2(gelu_tanh(x1[0]), gelu_tanh(x1[1])); w.w = pk2(gelu_tanh(x1[2]), gelu_tanh(x1[3])); return w; }
constexpr int CW_STRIDE = 272, CW_CC = 2 * 64 * CW_STRIDE;
__device__ __forceinline__ void cmp_combine_item(const Params& P, LAS unsigned char* lds, int lane, int ba, int hkv, int type, int mt) {
    unsigned char* ws = P.ws; const int r32 = lane & 31, hi = lane >> 5, view = type * 2 + hkv;
    const bf16* OC = (const bf16*)(ws + WS_OUTC) + (size_t)view * NBA * 128 * 256; const LAS float* cc = (const LAS float*)(lds + CW_CC) + type * 128;
    const LAS unsigned char* W2 = lds + (type * 64 + r32) * CW_STRIDE + 16 * hi;
    const int i = 32 * mt + r32, i1 = i < 127 ? i + 1 : 127;
    f32x16 acc0 = (f32x16){}, acc1 = (f32x16){};
    if (ba >= DB) {
        const float* pv = (const float*)(ws + WS_T1) + (size_t)view * 32 * 1024 * 8; const int rl = (ba - DB) * 128 + i, rh = (ba - DB) * 128 + i1;
        constexpr size_t SLAB = (size_t)4 * 32 * 1024 * 8;
#pragma unroll 2
        for (int ks = 0; ks < 8; ++ks) { const float* plo = pv + ((size_t)(ks * 2 + hi) * 1024 + rl) * 8; const float* phh = pv + ((size_t)(16 + ks * 2 + hi) * 1024 + rh) * 8;
            f32x4 x0 = *(const LAS f32x4*)(cc + ks * 16 + 8 * hi), x1 = *(const LAS f32x4*)(cc + ks * 16 + 8 * hi + 4);
#pragma unroll
            for (int s = 0; s < SPLIT_C; ++s) { x0 = x0 + *(const f32x4*)(plo + s * SLAB) + *(const f32x4*)(phh + s * SLAB); x1 = x1 + *(const f32x4*)(plo + s * SLAB + 4) + *(const f32x4*)(phh + s * SLAB + 4); }
            const bf16x8 w = __builtin_bit_cast(bf16x8, gelu_pack(x0, x1));
            acc0 = __builtin_amdgcn_mfma_f32_32x32x16_bf16(w, *(const LAS bf16x8*)(W2 + ks * 32), acc0, 0, 0, 0);
            acc1 = __builtin_amdgcn_mfma_f32_32x32x16_bf16(w, *(const LAS bf16x8*)(W2 + 32 * CW_STRIDE + ks * 32), acc1, 0, 0, 0); }
    } else {
        const bf16* lo = OC + (size_t)(ba * 128 + i) * 256 + 8 * hi; const bf16* hh = OC + (size_t)(ba * 128 + i1) * 256 + 128 + 8 * hi;
        u32x4 av[8], cv[8];
#pragma unroll
        for (int ks = 0; ks < 8; ++ks) { av[ks] = *(const u32x4*)(lo + ks * 16); cv[ks] = *(const u32x4*)(hh + ks * 16); }
#pragma unroll
        for (int ks = 0; ks < 8; ++ks) { const u32x4 a = av[ks], c = cv[ks]; const f32x4 k0 = *(const LAS f32x4*)(cc + ks * 16 + 8 * hi), k1 = *(const LAS f32x4*)(cc + ks * 16 + 8 * hi + 4);
            const f32x4 x0 = (f32x4){bflo(a.x) + bflo(c.x), bfhi(a.x) + bfhi(c.x), bflo(a.y) + bflo(c.y), bfhi(a.y) + bfhi(c.y)} + k0, x1 = (f32x4){bflo(a.z) + bflo(c.z), bfhi(a.z) + bfhi(c.z), bflo(a.w) + bflo(c.w), bfhi(a.w) + bfhi(c.w)} + k1;
            const bf16x8 w = __builtin_bit_cast(bf16x8, gelu_pack(x0, x1));
            acc0 = __builtin_amdgcn_mfma_f32_32x32x16_bf16(w, *(const LAS bf16x8*)(W2 + ks * 32), acc0, 0, 0, 0);
            acc1 = __builtin_amdgcn_mfma_f32_32x32x16_bf16(w, *(const LAS bf16x8*)(W2 + 32 * CW_STRIDE + ks * 32), acc1, 0, 0, 0); }
    }
    bf16* O = (bf16*)(ws + (type ? WS_VC : WS_KC)) + (size_t)(ba * 2 + hkv) * 128 * 64;
#pragma unroll
    for (int r = 0; r < 16; ++r) { const int row = 32 * mt + att::crow(r, hi); O[(size_t)row * 64 + r32] = row < 127 ? (bf16)f2bf(acc0[r]) : (bf16)0; O[(size_t)row * 64 + 32 + r32] = row < 127 ? (bf16)f2bf(acc1[r]) : (bf16)0; }
}
__device__ __forceinline__ void cmp_combine_dispatch(const Params& P, LAS unsigned char* lds, int lane, int item) {
    const bool pr = item < 128; const int s = pr ? item : item - 128, u = s >> 2;
    cmp_combine_item(P, lds, lane, (pr ? DB : 0) + (u >> 2), (u >> 1) & 1, u & 1, s & 3);
}

__device__ __forceinline__ void ssm_phase(const Params& P, const Frame& F) {
    { LAS float* sw = (LAS float*)F.lds + F.wave * 512; LAS float* cw = (LAS float*)(F.lds + 16384) + F.wave * 2080;
      const bool std_grid = F.G == 256; const int c0 = (int)blockIdx.x, nb = std_grid ? 192 : F.G, ib = std_grid ? c0 - 64 : c0;
      if (ib >= 0) ssm::sample_wave(P, F, ib * NWAVES + F.wave, nb * NWAVES, sw, cw); }
    __builtin_amdgcn_sched_barrier(0);
    __syncthreads();
    const int c = (int)blockIdx.x, first = c;
#pragma unroll 1
    for (int v = first; v < 256; v += F.G) { const Frame Fu = launder(F); ssm::prompt_unit(P, Fu, v >> 5, v & 31); }
    __syncthreads();
}
__device__ __forceinline__ void misc_phase(const Params& P, const Frame& F) {
    constexpr int NIT = NBA * 4 * 4; const int gw = F.vcu * NWAVES + F.wave, NGW = F.G * NWAVES;
    if (NGW != 2048 || (int)blockIdx.x >= 132) {
        const unsigned char* wsrc = P.ws + WS_WC2;
#pragma unroll
        for (int p = 0; p < 4; ++p) { const int idx = p * NTHREADS + F.tid, row = idx >> 4, c16 = idx & 15; *(LAS u32x4*)(F.lds + row * CW_STRIDE + c16 * 16) = *(const u32x4*)(wsrc + (size_t)idx * 16); }
        if (F.tid < 64) *(LAS u32x4*)(F.lds + CW_CC + F.tid * 16) = *(const u32x4*)(P.ws + WS_CCON + F.tid * 16);
        __syncthreads(); }
    if (NGW == 2048) {
        const int b = (int)blockIdx.x, w = F.wave, hb = b - 132; int it0 = -1, it1 = -1, it2 = -1;
        if (hb >= 0) {
            if (w == 0) { it0 = hb; it1 = 128 + hb; }
            else { const int s = 124 + (hb * 7 + w - 1) * 2; it0 = 128 + s; it1 = 128 + s + 1;
                if (w <= 2) { const int e = hb * 2 + w - 1; it2 = e < 188 ? 128 + 1860 + e : (e < 192 ? 124 + e - 188 : -1); } } }
#pragma unroll 1
        for (int k = 0; k < 3; ++k) { const int it = k == 0 ? it0 : (k == 1 ? it1 : it2); if (it >= 0) { const Frame Fu = launder(F); cmp_combine_dispatch(P, Fu.lds, Fu.lane, it); } }
    } else {
#pragma unroll 1
        for (int it = gw; it < NIT; it += NGW) { const Frame Fu = launder(F); cmp_combine_dispatch(P, Fu.lds, Fu.lane, it); }
    }
}

template <int KIND, int NSPLIT> __device__ __forceinline__ void fix_phase(const Params& P, const Frame& F, const float* base, float scale, const float* ssq_in, float* ssq_out) {
    unsigned char* ws = P.ws; const float* part = (const float*)(ws + WS_T1); float* xr = (float*)(ws + WS_XR); bf16* xb = (bf16*)(ws + WS_XB); const bf16* pp = (const bf16*)(ws + WS_PP);
    const int gw = F.vcu * NWAVES + F.wave, NGW = F.G * NWAVES, lane = F.lane;
    for (int it = gw; it < NSR * 4; it += NGW) { const int sr = it >> 2, j = it & 3; const size_t row = (size_t)NP + sr; const int col = 256 * j + 4 * lane;
        f32x4 pv[NSPLIT];
#pragma unroll
        for (int ks = 0; ks < NSPLIT; ++ks) pv[ks] = *(const f32x4*)(part + ((size_t)ks * NSR + sr) * DM + col);
        f32x4 a = pv[0];
#pragma unroll
        for (int ks = 1; ks < NSPLIT; ++ks) a = a + pv[ks];
        f32x4 x;
        if (KIND == 0) x = *(const f32x4*)(base + (size_t)sr * DM + col) + a * scale;
        else { const float rs = rstd_of(ssq_in[row]); const u32x2 w = *(const u32x2*)(pp + row * DM + col); x = *(const f32x4*)(xr + row * DM + col);
            x[0] += sigmoidf_(a[0] * rs) * bflo(w.x); x[1] += sigmoidf_(a[1] * rs) * bfhi(w.x); x[2] += sigmoidf_(a[2] * rs) * bflo(w.y); x[3] += sigmoidf_(a[3] * rs) * bfhi(w.y); }
        *(f32x4*)(xr + row * DM + col) = x; u32x2 o; o.x = pk2(x[0], x[1]); o.y = pk2(x[2], x[3]); *(u32x2*)(xb + row * DM + col) = o;
        const float ss = wave_sum((x[0] * x[0] + x[1] * x[1]) + (x[2] * x[2] + x[3] * x[3])); if (lane == 0) atomicAdd(ssq_out + row, ss); }
}

__device__ __forceinline__ void final_phase(const Params& P, const Frame& F) {
    const float* xr = (const float*)(P.ws + WS_XR); const float* ssq = (const float*)(P.ws + WS_SSQ) + 3 * MR; const float* gf = P.in[I_GFIN];
    const int gw = F.vcu * NWAVES + F.wave, NGW = F.G * NWAVES, lane = F.lane;
    f32x4 gv[4];
#pragma unroll
    for (int j = 0; j < 4; ++j) gv[j] = *(const f32x4*)(gf + 256 * j + 4 * lane);
    const bf16* xq = (const bf16*)(P.ws + WS_TT);
    for (int m = gw; m < MR; m += NGW) { const float rs = rstd_of(ssq[m]);
        if (m < NP) {
#pragma unroll
            for (int j = 0; j < 4; ++j) { const u32x2 w = *(const u32x2*)(xq + (size_t)m * DM + 256 * j + 4 * lane); const f32x4 v = (f32x4){bflo(w.x), bfhi(w.x), bflo(w.y), bfhi(w.y)}; *(f32x4*)(P.out + (size_t)m * DM + 256 * j + 4 * lane) = v * rs * gv[j]; } }
        else {
#pragma unroll
            for (int j = 0; j < 4; ++j) { const f32x4 v = *(const f32x4*)(xr + (size_t)m * DM + 256 * j + 4 * lane); *(f32x4*)(P.out + (size_t)m * DM + 256 * j + 4 * lane) = v * rs * gv[j]; } } }
}
#define XB_TMO      128
#define XB_XCNT(j)  (256  + 64 * (j))
#define XB_XSUB(j)  (1280 + 64 * (j))
#define XB_XGEN(j)  (2304 + 64 * (j))
#define XB_TOP      3328
#define XB_TOPGEN   3392
#define XCD_BAR_WORDS 3456
#define XB_SPIN_CAP (1u << 18)

__device__ __forceinline__ unsigned xb_ld(unsigned* p)              { return __hip_atomic_load(p, __ATOMIC_RELAXED, __HIP_MEMORY_SCOPE_AGENT); }
__device__ __forceinline__ unsigned xb_add(unsigned* p, unsigned v) { return __hip_atomic_fetch_add(p, v, __ATOMIC_RELAXED, __HIP_MEMORY_SCOPE_AGENT); }
__device__ __forceinline__ unsigned xb_xcc_id() { return (unsigned)__builtin_amdgcn_s_getreg((3 << 11) | 20) & 0xFu; }
#define XB_SPIN(cond, bar) do { unsigned _sp = 0; while (cond) { __builtin_amdgcn_s_sleep(1); \
    if ((++_sp & 255u) == 0u) { if (xb_ld(&(bar)[XB_TMO])) break; if (_sp > XB_SPIN_CAP) { atomicAdd(&(bar)[XB_TMO], 1u); break; } } } } while (0)

struct XcdBarrier {
    unsigned* bar; unsigned x;
    volatile LAS unsigned* st;
};

__device__ __forceinline__ XcdBarrier xcd_barrier_post(unsigned* bar, volatile LAS unsigned* st) {
    XcdBarrier b; b.bar = bar; b.x = xb_xcc_id(); b.st = st;
    if (threadIdx.x == 0) (void)xb_add(&bar[XB_XCNT(b.x)], 1u);
    return b;
}
__device__ __forceinline__ void xcd_barrier_complete(unsigned* bar, unsigned x, unsigned& nloc, unsigned& nx) {
    const unsigned G = gridDim.x * gridDim.y * gridDim.z;
    unsigned sum, cnt, mine, sp = 0u;
    for (;;) {
        sum = 0u; cnt = 0u; mine = 0u;
#pragma unroll
        for (unsigned j = 0; j < 16; ++j) { const unsigned c = xb_ld(&bar[XB_XCNT(j)]); sum += c; cnt += (c > 0u) ? 1u : 0u; mine = (j == x) ? c : mine; }
        if (sum == G) break;
        __builtin_amdgcn_s_sleep(1);
        if ((++sp & 255u) == 0u) { if (xb_ld(&bar[XB_TMO])) break; if (sp > XB_SPIN_CAP) { atomicAdd(&bar[XB_TMO], 1u); break; } }
    }
    nloc = mine > 0u ? mine : 1u; nx = cnt > 0u ? cnt : 1u;
}

__device__ __forceinline__ void xcd_barrier(const XcdBarrier& b) {
    asm volatile("s_waitcnt vmcnt(0)" ::: "memory");
    __syncthreads();
    if (threadIdx.x == 0) {
        unsigned* bar = b.bar;
        __builtin_amdgcn_s_waitcnt(0);
        unsigned nloc = b.st[0], nx = b.st[1];
        if (nloc == 0u) { xcd_barrier_complete(bar, b.x, nloc, nx); b.st[0] = nloc; b.st[1] = nx; }
        const unsigned old = xb_add(&bar[XB_XSUB(b.x)], 1u);
        const unsigned gen = old / nloc;
        if (old + 1u == (gen + 1u) * nloc) {
            __builtin_amdgcn_fence(__ATOMIC_RELEASE, "agent");
            asm volatile("s_waitcnt vmcnt(0)" ::: "memory");
            const unsigned og = xb_add(&bar[XB_TOP], 1u);
            const unsigned tg = og / nx;
            if (og + 1u == (tg + 1u) * nx) xb_add(&bar[XB_TOPGEN], 1u);
            else XB_SPIN(xb_ld(&bar[XB_TOPGEN]) == tg, bar);
            __builtin_amdgcn_fence(__ATOMIC_ACQUIRE, "agent");
            xb_add(&bar[XB_XGEN(b.x)], 1u);
            asm volatile("s_waitcnt vmcnt(0)" ::: "memory");
        } else {
            XB_SPIN(xb_ld(&bar[XB_XGEN(b.x)]) == gen, bar);
            __builtin_amdgcn_fence(__ATOMIC_ACQUIRE, "agent");
            asm volatile("s_waitcnt vmcnt(0)" ::: "memory");
        }
    }
    __syncthreads();
}


constexpr int LDS_BYTES = 147456;
enum Phase { PH_PRO = 0, PH_GU1, PH_D1, PH_FIX1, PH_WIN, PH_CMPG, PH_SSM, PH_MISC, PH_GLU, PH_ATT, PH_MG1, PH_MG2, PH_WOUT, PH_FIX2, PH_GU2, PH_D2, PH_FIX3, PH_PPROJ, PH_PGATE, PH_FIX4, PH_FINAL, PH_N };
constexpr int SPLIT_D = 11, SPLIT_O = 4;

#ifndef PH_MASK
#define PH_MASK 0x1FFFFF
#endif
#define EN(k) (((PH_MASK) >> (k)) & 1)
template <int PH> __device__ __forceinline__ void run_phase(const Params& P, const Frame& F, unsigned char* ws) {
    using namespace pg8;
    float* ssq1 = (float*)(ws + WS_SSQ); float* ssq2 = ssq1 + MR; float* ssq3 = ssq2 + MR; float* ssq4 = ssq3 + MR; const float* ssq0 = (const float*)(ws + WS_SSQ0);
    bf16* XB = (bf16*)(ws + WS_XB); float* XR = (float*)(ws + WS_XR); bf16* H = (bf16*)(ws + WS_H);
    Gemm g{}; g.vt = 0; g.vstride = 0; g.bdiv = 0; g.kstepA = BK; g.M = MR;
    StaticOrder S;
    if constexpr (!EN(PH)) { return; }
    else if constexpr (PH == PH_PRO) prologue(P, F);
    else if constexpr (PH == PH_GU1 || PH == PH_GU2) { constexpr bool two = PH == PH_GU2;
        g.A = XB; g.Bt = (const bf16*)(ws + (two ? WS_WGU2 : WS_WGU1)); g.N = 2 * FF; g.K = DM; g.lda = DM; S.init(MR, 2 * FF, F.G, (int)blockIdx.x, DM);
        EpiSwiglu E{H, FF, two ? ssq2 : ssq0};
        gemm_phase<EpiSwiglu, StaticOrder, true, true>(F.lds, g, S, E); }
    else if constexpr (PH == PH_D1 || PH == PH_D2 || PH == PH_WOUT) {
        EpiResid E;
        if constexpr (PH == PH_D1) { g.A = H; g.Bt = (const bf16*)(ws + WS_WD1); g.K = FF; g.lda = FF; E = EpiResid{P.in[I_XP], P.in[I_XS], XR, XB, ssq1, 0.5f, nullptr, 2}; }
        else if constexpr (PH == PH_D2) { g.A = H; g.Bt = (const bf16*)(ws + WS_WD2); g.K = FF; g.lda = FF; E = EpiResid{XR, XR + (size_t)NP * DM, XR, XB, ssq3, 0.5f, (float*)(ws + WS_T1), 3}; }
        else { g.A = (const bf16*)(ws + WS_TT); g.Bt = (const bf16*)(ws + WS_WOUT); g.K = DM; g.lda = DM; E = EpiResid{XR, XR + (size_t)NP * DM, XR, XB, ssq2, 1.0f, (float*)(ws + WS_T1), 3}; }
        g.N = DM;
        if constexpr (PH == PH_D1) { S.init(MR, DM, F.G, (int)blockIdx.x, g.K); gemm_phase<EpiResid, StaticOrder, true, true>(F.lds, g, S, E);
            if (F.G == 256) { if ((int)blockIdx.x >= 8) { const int ib = (int)blockIdx.x - 8; for (int it = ib; it < 256; it += 248) ssm_tables_item(P, (LAS float*)F.lds, it, F.tid);
                    background_copy<1 | 8>(P, ib * NWAVES + F.wave, 248 * NWAVES, F.lane, (LAS float*)(F.lds + F.wave * 16384)); } }
            else { for (int it = blockIdx.x; it < 256; it += F.G) ssm_tables_item(P, (LAS float*)F.lds, it, F.tid);
                background_copy<63>(P, (int)blockIdx.x * NWAVES + F.wave, F.G * NWAVES, F.lane, (LAS float*)(F.lds + F.wave * 16384)); }
        } else { S.init(MR, DM, F.G, (int)blockIdx.x, g.K, NP, PH == PH_WOUT ? SPLIT_O : SPLIT_D); gemm_phase<EpiResid, StaticOrder, true, true>(F.lds, g, S, E); } }
    else if constexpr (PH == PH_WIN) { g.A = XB; g.Bt = (const bf16*)(ws + WS_WIN); g.N = NIN; g.K = DM; g.lda = DM; S.init(MR, NIN, F.G, (int)blockIdx.x, DM);
        EpiWin E{ssq1, P.out, (bf16*)(ws + WS_Q), (bf16*)(ws + WS_CCB) + (size_t)DB * 2048 * 256, (bf16*)(ws + WS_KVS), (bf16*)(ws + WS_KVW), (bf16*)(ws + WS_U), (bf16*)(ws + WS_MG), (float*)(ws + WS_NG)};
        gemm_phase<EpiWin, StaticOrder, true, true>(F.lds, g, S, E);
        if (F.G == 256 && (int)blockIdx.x >= 32) background_copy<2 | 4>(P, ((int)blockIdx.x - 32) * NWAVES + F.wave, 224 * NWAVES, F.lane, (LAS float*)(F.lds + F.wave * 16384)); }
    else if constexpr (PH == PH_CMPG) { g.A = (const bf16*)(ws + WS_CCB); g.Bt = (const bf16*)(ws + WS_WC1); g.M = 4 * NBA * 128; g.N = 256; g.K = 1024; g.lda = 4096; g.kstepA = 256; g.vt = NBA * 128 / 256; g.vstride = 64; g.bdiv = 2 * (NBA * 128 / 256);
        EpiPlain E{(bf16*)(ws + WS_OUTC), 256, (float*)(ws + WS_T1), NBA * 128 / 256, DB * 128 / 256}; S.init_views(4, NBA * 128 / 256, DB * 128 / 256, SPLIT_C, 1024, F.G, (int)blockIdx.x);
        gemm_phase<EpiPlain, StaticOrder, true, true>(F.lds, g, S, E); }
    else if constexpr (PH == PH_PPROJ) { g.A = (const bf16*)(ws + WS_PB); g.Bt = (const bf16*)(ws + WS_WPP); g.N = DM; g.K = PLE; g.lda = PLE; EpiPlain E{(bf16*)(ws + WS_PP), DM, nullptr, 1, 1}; S.init(MR, DM, F.G, (int)blockIdx.x, PLE);
        gemm_phase<EpiPlain, StaticOrder, true, true>(F.lds, g, S, E); }
    else if constexpr (PH == PH_SSM) ssm_phase(P, F);
    else if constexpr (PH == PH_MISC) misc_phase(P, F);
    else if constexpr (PH == PH_ATT) att::attn_phase(P, F);
    else if constexpr (PH == PH_GLU) { g.A = (const bf16*)(ws + WS_YG); g.Bt = (const bf16*)(ws + WS_WGLU); g.N = 512; g.K = 512; g.lda = 512; S.init(MR, 512, F.G, (int)blockIdx.x, 512);
        EpiGlu E{(const bf16*)(ws + WS_YG), (bf16*)(ws + WS_AO)};
        gemm_phase<EpiGlu, StaticOrder, true, true>(F.lds, g, S, E);
    }
    else if constexpr (PH == PH_MG1) { g.A = (const bf16*)(ws + WS_AO); g.Bt = (const bf16*)(ws + WS_WBA); g.N = DM; g.K = DM; g.lda = DM; S.init(MR, DM, F.G, (int)blockIdx.x, DM);
        EpiMerge E{(const bf16*)(ws + WS_MG), (bf16*)(ws + WS_TT)};
        gemm_phase<EpiMerge, StaticOrder, true, true>(F.lds, g, S, E);
        if (F.G == 256 && (int)blockIdx.x >= 8) background_copy<16 | 32>(P, ((int)blockIdx.x - 8) * NWAVES + F.wave, 248 * NWAVES, F.lane, (LAS float*)(F.lds + F.wave * 16384)); }
    else if constexpr (PH == PH_PGATE) { g.A = XB; g.Bt = (const bf16*)(ws + WS_WPG); g.N = DM; g.K = DM; g.lda = DM; S.init(MR, DM, F.G, (int)blockIdx.x, DM, NP, SPLIT_O);
        EpiPleGate E{ssq3, (const bf16*)(ws + WS_PP), XR, ssq4, (float*)(ws + WS_T1), XB, (bf16*)(ws + WS_TT)};
        gemm_phase<EpiPleGate, StaticOrder, true, true>(F.lds, g, S, E); }
    else if constexpr (PH == PH_FIX2) fix_phase<0, SPLIT_O>(P, F, XR + (size_t)NP * DM, 1.0f, nullptr, ssq2);
    else if constexpr (PH == PH_FIX3) fix_phase<0, SPLIT_D>(P, F, XR + (size_t)NP * DM, 0.5f, nullptr, ssq3);
    else if constexpr (PH == PH_FIX4) fix_phase<1, SPLIT_O>(P, F, nullptr, 0.f, ssq3, ssq4);
    else if constexpr (PH == PH_FINAL) final_phase(P, F);
}

__global__ void __launch_bounds__(NTHREADS, 2) mega_fwd(Params P) {
    extern __shared__ __attribute__((aligned(16))) unsigned char lds_raw[];
    Frame F0; F0.lds = (LAS unsigned char*)lds_raw; F0.tid = threadIdx.x; F0.lane = F0.tid & 63; F0.wave = __builtin_amdgcn_readfirstlane(F0.tid >> 6);
    F0.G = gridDim.x; { const int bx = blockIdx.x; F0.vcu = (F0.G % 8 == 0) ? (bx % 8) * (F0.G / 8) + bx / 8 : bx; }
    const int lo = P.ph_lo, hi = P.ph_hi;
#ifdef CODE_PAD
    asm volatile(".rept " CODE_PAD "\n\ts_nop 0\n\t.endr");
#endif
    volatile LAS unsigned* bst = (volatile LAS unsigned*)(F0.lds + LDS_BYTES - 64);
    if (F0.tid < 2) bst[F0.tid] = 0u;
    __syncthreads();
    XcdBarrier bar; bar.bar = (unsigned*)(P.ws + WS_CTL) + 1024; bar.x = 0; bar.st = bst;
    if (P.coop) bar = xcd_barrier_post((unsigned*)(P.ws + WS_CTL) + 1024, bst);
#ifdef TPROBE
#ifndef TP_A0
#define TP_A0 0
#define TP_A1 256
#define TP_B0 0
#define TP_B1 256
#endif
#define TSTAMP(k) if (threadIdx.x == 0) { ((unsigned long long*)(P.ws + WS_CTL + (1u << 20)))[(k) * 256 + blockIdx.x] = __builtin_amdgcn_s_memrealtime(); }
    TSTAMP(21)
#else
#define TSTAMP(k)
#endif
#define RUN(k) if ((k) != PH_FIX1 && (k) != PH_MG2 && lo <= (k) && (k) < hi) { Frame F = launder(F0); unsigned char* ws = P.ws; asm volatile("" : "+s"(ws)); run_phase<k>(P, F, ws); TSTAMP(k) if ((k) == PH_CMPG || (k) == PH_MISC || (k) == PH_FIX3) { __builtin_amdgcn_sched_barrier(0); __syncthreads(); asm volatile("" ::: "memory"); } else if ((k) + 1 < hi && P.coop) { if (P.coop == 2) cg::this_grid().sync(); else xcd_barrier(bar); } }
    RUN(0) RUN(1) RUN(2) RUN(3) RUN(4) RUN(5) RUN(6) RUN(7) RUN(8) RUN(9) RUN(10) RUN(11) RUN(12) RUN(13) RUN(14) RUN(15) RUN(16) RUN(17) RUN(18) RUN(19) RUN(20)
#undef RUN
#ifdef TPROBE
    xcd_barrier(bar);
    if (blockIdx.x == 0 && threadIdx.x == 0) { const volatile unsigned long long* ts = (const volatile unsigned long long*)(P.ws + WS_CTL + (1u << 20));
        unsigned long long qa, qb;
        { unsigned long long mk = 0, mp = 0, np = ~0ull;
#pragma unroll 1
            for (int b = 0; b < 256; ++b) { const unsigned long long a = (b >= TP_A0 && b < TP_A1) ? ts[TP_KA * 256 + b] : 0ull, c = ts[TP_PA * 256 + b]; mk = a > mk ? a : mk; mp = c > mp ? c : mp; np = c < np ? c : np; }
            qa = mk - ((TP_PA == TP_KA || TP_PA == 21) ? np : mp); }
        { unsigned long long mk = 0, mp = 0, np = ~0ull;
#pragma unroll 1
            for (int b = 0; b < 256; ++b) { const unsigned long long a = (b >= TP_B0 && b < TP_B1) ? ts[TP_KB * 256 + b] : 0ull, c = ts[TP_PB * 256 + b]; mk = a > mk ? a : mk; mp = c > mp ? c : mp; np = c < np ? c : np; }
            qb = mk - ((TP_PB == TP_KB || TP_PB == 21) ? np : mp); }
        const unsigned long long ticks = qa * 10 + (qb / 200) * 250000ull, t0 = __builtin_amdgcn_s_memrealtime();
        while (__builtin_amdgcn_s_memrealtime() - t0 < ticks) __builtin_amdgcn_s_sleep(20);
    }
#endif
}

extern "C" void kernel_launch(void* const* d_in, const int* in_sizes, int n_in, void* d_out, int out_size, void* d_ws, size_t ws_size, hipStream_t stream) {
    static int grid = 0;
    if (grid == 0) {
        if (n_in != 45 || (size_t)out_size != O_END || ws_size < WS_END) { fprintf(stderr, "kernel_launch: unexpected shapes: n_in %d out %d ws %zu (need %zu)\n", n_in, out_size, ws_size, (size_t)WS_END); grid = -1; return; }
        int dev = 0, cus = 0, per_cu = 0;
        (void)hipGetDevice(&dev); (void)hipDeviceGetAttribute(&cus, hipDeviceAttributeMultiprocessorCount, dev);
        if (hipFuncSetAttribute((const void*)mega_fwd, hipFuncAttributeMaxDynamicSharedMemorySize, LDS_BYTES) != hipSuccess) { fprintf(stderr, "kernel_launch: hipFuncSetAttribute failed\n"); grid = -1; return; }
        if (hipOccupancyMaxActiveBlocksPerMultiprocessor(&per_cu, (const void*)mega_fwd, NTHREADS, LDS_BYTES) != hipSuccess || per_cu < 1) { fprintf(stderr, "kernel_launch: occupancy query says %d blocks per CU\n", per_cu); per_cu = 1; }
        (void)hipGetLastError();
        grid = cus;
        if (grid <= 0) grid = 256;
    }
    if (grid < 0) return;
    (void)hipMemsetAsync((char*)d_ws + WS_CTL, 0, CTL_BYTES, stream);
    Params p{};
    for (int i = 0; i < 45; ++i) p.in[i] = (const float*)d_in[i];
    p.out = (float*)d_out; p.ws = (unsigned char*)d_ws;
    for (int n = 0; n < 128; ++n) { int bk; if (n < 16) bk = n; else { bk = 16 + (int)(std::log((double)n / 16.0) / std::log(8.0) * 16.0); if (bk > 31) bk = 31; } p.bucket[n] = (unsigned char)bk; }
#if MK_ONE_LAUNCH
    p.ph_lo = 0; p.ph_hi = PH_N; p.coop = 1;
    void* args[] = {&p};
    hipError_t e = hipLaunchCooperativeKernel((const void*)mega_fwd, dim3(grid), dim3(NTHREADS), args, LDS_BYTES, stream);
    if (e != hipSuccess) fprintf(stderr, "kernel_launch: cooperative launch failed: %s (grid %d)\n", hipGetErrorString(e), grid);
#else
    for (int ph = 0; ph < PH_N; ++ph) { p.ph_lo = ph; p.ph_hi = ph + 1; p.coop = 0; hipLaunchKernelGGL(mega_fwd, dim3(grid), dim3(NTHREADS), LDS_BYTES, stream, p); }
#endif
}
```

```cpp
#include <hip/hip_runtime.h>
#include <hip/hip_cooperative_groups.h>
#include <cstdio>
#include <cstdint>
#include <cmath>
namespace cg = cooperative_groups;

#define LAS __attribute__((address_space(3)))
#define GAS __attribute__((address_space(1)))
typedef unsigned short bf16;
typedef short bf16x8 __attribute__((ext_vector_type(8)));
typedef short s16x4 __attribute__((ext_vector_type(4)));
typedef float f32x4 __attribute__((ext_vector_type(4)));
typedef float f32x2 __attribute__((ext_vector_type(2)));
typedef float f32x16 __attribute__((ext_vector_type(16)));
typedef unsigned u32x4 __attribute__((ext_vector_type(4)));
typedef unsigned u32x2 __attribute__((ext_vector_type(2)));

constexpr int DM = 1024, NP = 16384, NSR = 512, MR = NP + NSR;
constexpr int SEQ = 2048, NB = 8, DB = 128, DS = 4, PAST = 2048, NBA = DB + NB;
constexpr int FF = 2816, NIN = 4096, PLE = 256;
constexpr int NWAVES = 8, NTHREADS = 512;
constexpr float RMS_EPS = 1e-6f;
constexpr float LOG2E = 1.4426950408889634f;

constexpr size_t O_YP = 0, O_YS = O_YP + (size_t)NP * DM, O_KVCP = O_YS + (size_t)NSR * DM, O_KVSP = O_KVCP + (size_t)NP * 256, O_KVWP = O_KVSP + (size_t)NP * 256,
                 O_SREP = O_KVWP + (size_t)NB * 512 * 256, O_SIMP = O_SREP + NB * 32 * 64, O_KVCS = O_SIMP + NB * 32 * 64, O_KVSS = O_KVCS + (size_t)NSR * 256,
                 O_KVWS = O_KVSS + (size_t)NSR * 256, O_SRES = O_KVWS + (size_t)DB * 512 * 256, O_SIMS = O_SRES + DB * 32 * 64, O_END = O_SIMS + DB * 32 * 64;

constexpr size_t al256(size_t x) { return (x + 255) & ~(size_t)255; }
constexpr size_t WS_CTL = 0, CTL_BYTES = 2u << 20;
constexpr size_t WS_SSQ = 65536;
constexpr size_t WS_SSQ0 = CTL_BYTES;
constexpr size_t WS_WGU1 = al256(WS_SSQ0 + (size_t)MR * 4);
constexpr size_t WS_WD1 = WS_WGU1 + (size_t)2 * FF * DM * 2;
constexpr size_t WS_WIN = WS_WD1 + (size_t)DM * FF * 2;
constexpr size_t WS_WGLU = WS_WIN + (size_t)NIN * DM * 2;
constexpr size_t WS_WBA = WS_WGLU + (size_t)512 * 512 * 2;
constexpr size_t WS_WBS = WS_WBA + (size_t)DM * 512 * 2;
constexpr size_t WS_WOUT = WS_WBS + (size_t)DM * 512 * 2;
constexpr size_t WS_WGU2 = WS_WOUT + (size_t)DM * DM * 2;
constexpr size_t WS_WD2 = WS_WGU2 + (size_t)2 * FF * DM * 2;
constexpr size_t WS_WPG = WS_WD2 + (size_t)DM * FF * 2;
constexpr size_t WS_WPP = WS_WPG + (size_t)DM * DM * 2;
constexpr size_t WS_WC1 = WS_WPP + (size_t)DM * PLE * 2;
constexpr size_t WS_WC2 = WS_WC1 + (size_t)2 * 256 * 1024 * 2;
constexpr size_t WS_XB = al256(WS_WC2 + (size_t)2 * 64 * 128 * 2);
constexpr size_t WS_XR = WS_XB + (size_t)MR * DM * 2;
constexpr size_t WS_H = WS_XR + (size_t)MR * DM * 4;
constexpr size_t WS_Q = WS_H + (size_t)MR * FF * 2;
constexpr size_t WS_KVS = WS_Q + (size_t)MR * 512 * 2;
constexpr size_t WS_KVW = WS_KVS + (size_t)MR * 256 * 2;
constexpr size_t WS_U = WS_KVW + (size_t)MR * 256 * 2;
constexpr size_t WS_NG = WS_U + (size_t)MR * 512 * 2;
constexpr size_t WS_MG = al256(WS_NG + (size_t)MR * 24 * 4);
constexpr size_t WS_AO = WS_MG + (size_t)MR * 2048 * 2;
constexpr size_t WS_YG = WS_AO + (size_t)MR * DM * 2;
constexpr size_t WS_T1 = WS_YG + (size_t)MR * 512 * 2;
constexpr size_t WS_TT = WS_T1 + (size_t)MR * DM * 4;
constexpr size_t WS_PP = WS_TT + (size_t)MR * DM * 2;
constexpr size_t WS_PB = WS_PP + (size_t)MR * DM * 2;
constexpr size_t WS_CCB = WS_PB + (size_t)MR * PLE * 2;
constexpr size_t WS_OUTC = WS_CCB + (size_t)NBA * 2048 * 256 * 2;
constexpr size_t WS_KC = WS_OUTC + (size_t)4 * NBA * 128 * 256 * 2;
constexpr size_t WS_VC = WS_KC + (size_t)NBA * 2 * 128 * 64 * 2;
constexpr size_t WS_TZ = WS_VC + (size_t)NBA * 2 * 128 * 64 * 2;
constexpr size_t WS_PT = WS_TZ + (size_t)32 * 512 * 512 * 2;
constexpr size_t WS_WC = WS_PT + (size_t)32 * 128 * 512 * 2;
constexpr size_t WS_ABT = WS_WC + (size_t)32 * 512 * 128 * 2;
constexpr size_t WS_ABL = WS_ABT + 32 * 64 * 2 * 4;
constexpr size_t WS_BBT = WS_ABL + 32 * 64 * 2 * 4;
constexpr size_t WS_BIAS = WS_BBT + 32 * 64 * 16 * 2 * 4;
constexpr size_t WS_CCON = 32768;
constexpr size_t WS_END = al256(WS_BIAS + 8 * 136 * 4);

__device__ __forceinline__ unsigned f2bf(float f) { unsigned u = __builtin_bit_cast(unsigned, f); return (u + 0x7fffu + ((u >> 16) & 1u)) >> 16; }
__device__ __forceinline__ unsigned pk2(float lo, float hi) {
    typedef __bf16 bf16x2_t __attribute__((ext_vector_type(2)));
    f32x2 v = {lo, hi}; bf16x2_t b = __builtin_convertvector(v, bf16x2_t); return __builtin_bit_cast(unsigned, b); }
__device__ __forceinline__ float bflo(unsigned w) { return __builtin_bit_cast(float, w << 16); }
__device__ __forceinline__ float bfhi(unsigned w) { return __builtin_bit_cast(float, w & 0xffff0000u); }
__device__ __forceinline__ float bf2f(bf16 h) { return __builtin_bit_cast(float, (unsigned)h << 16); }
__device__ __forceinline__ float fast_exp2(float x) { return __builtin_amdgcn_exp2f(x); }
__device__ __forceinline__ float fast_rcp(float x) { return __builtin_amdgcn_rcpf(x); }
__device__ __forceinline__ float sigmoidf_(float x) { return fast_rcp(1.0f + fast_exp2(-x * LOG2E)); }
__device__ __forceinline__ float siluf_(float x) { return x * sigmoidf_(x); }
__device__ __forceinline__ float gelu_tanh(float x) { const float z = 0.7978845608028654f * (x + 0.044715f * x * x * x); return x * fast_rcp(1.0f + fast_exp2(-2.0f * LOG2E * z)); }
__device__ __forceinline__ float rstd_of(float ssq) { return 1.0f / sqrtf(ssq * (1.0f / DM) + RMS_EPS); }
#define LDS_WAIT() asm volatile("s_waitcnt lgkmcnt(0)" ::: "memory")
#ifndef MK_ONE_LAUNCH
#define MK_ONE_LAUNCH 1
#endif
namespace pg8 {
#define PG8_LAS __attribute__((address_space(3)))
typedef unsigned short bf16_t;
typedef short bf16x8 __attribute__((ext_vector_type(8)));
typedef float f32x4 __attribute__((ext_vector_type(4)));
typedef unsigned u32x4 __attribute__((ext_vector_type(4)));
constexpr int BM = 256, BK = 64, HALF = 128, HTB = HALF * BK * 2  , STAGE_BYTES = 8 * HTB, NXCD = 8, WGM = 8;

__host__ __device__ __forceinline__ int lds_byte(int r, int c) { const int st = (r >> 4) * 2 + (c >> 5), rr = r & 15, cc = c & 31, ob = rr * 64 + cc * 2; return st * 1024 + (ob ^ (((ob >> 9) & 1) << 5)); }
__host__ __device__ __forceinline__ void stage_rc(int b, int& R, int& C) { const int st = b / 1024, sb = b % 1024, swz = sb ^ (((sb >> 9) & 1) << 5); R = (st >> 1) * 16 + swz / 64; C = (st & 1) * 32 + (swz % 64) / 2; }
__host__ __device__ __forceinline__ int perm32(int rho) { const int n = rho >> 4, i = rho & 15; return 8 * (i >> 2) + 4 * n + (i & 3); }

struct Unit { int pm, pn, kt0, nt; };
struct Gemm { const bf16_t* A; const bf16_t* Bt; int M, N, K; int lda, kstepA; int vt, vstride, bdiv;
    __device__ __forceinline__ const char* a_tile(const Unit& u) const {
        const size_t off = vt ? (size_t)(u.pm / vt) * vstride + (size_t)(u.pm % vt) * 256 * lda : (size_t)u.pm * 256 * lda; return (const char*)(A + off + (size_t)u.kt0 * kstepA); }
    __device__ __forceinline__ const char* b_tile(const Unit& u) const { const int bi = bdiv ? u.pm / bdiv : u.pn; return (const char*)(Bt + (size_t)bi * 256 * K + (size_t)u.kt0 * BK); }
};

struct StaticOrder {
    int nM, nN, nwg, G, c, nMf, split, ntf, nfull, vt, vfull;
    __host__ __device__ void init(int M, int N, int G_, int c_, int K = 0, int Mfull = -1, int split_ = 1) { nM = M / BM; nN = N / BM; G = G_; c = c_; ntf = K / BK;
        nMf = Mfull < 0 ? nM : Mfull / BM; split = split_; nfull = nMf * nN; nwg = nfull + (nM - nMf) * nN * split; vt = 0; vfull = 0; }
    __host__ __device__ void init_views(int nviews, int vt_, int vfull_, int split_, int K, int G_, int c_) { nM = nviews * vt_; nN = 1; G = G_; c = c_; ntf = K / BK; vt = vt_; vfull = vfull_; split = split_;
        nMf = nM; nfull = nviews * vfull_; nwg = nfull + nviews * (vt_ - vfull_) * split_; }
    __host__ __device__ bool next(int i, Unit& u) const {
        const long L = (long)i * G + c; if (L >= nwg) return false;
        const bool sp = L >= nfull;
        const int idx = (int)L - nfull, per = nN * split, rem = idx % per, snt = ntf / split;
        int wgid = (int)L; { const int q = nfull / NXCD, r = nfull % NXCD, xcd = wgid % NXCD, off = wgid / NXCD; wgid = (xcd < r ? xcd * (q + 1) : r * (q + 1) + (xcd - r) * q) + off; }
        const int nig = WGM * nN, gid = wgid / nig, fm = gid * WGM, gsz = (nMf - fm) < WGM ? (nMf - fm) : WGM;
        const int fpm = fm + ((wgid % nig) % (gsz > 0 ? gsz : 1)), fpn = (wgid % nig) / (gsz > 0 ? gsz : 1);
        Unit r; r.pm = sp ? nMf + idx / per : fpm; r.pn = sp ? rem / split : fpn; r.kt0 = sp ? (rem % split) * snt : 0; r.nt = sp ? snt : ntf;
        if (vt) { const int vrest = vt - vfull, u16 = idx / split, fl = (int)L;
            r.pm = sp ? (u16 / vrest) * vt + vfull + (u16 % vrest) : (fl / vfull) * vt + (fl % vfull); r.pn = 0; r.kt0 = sp ? (idx % split) * snt : 0; }
        u = r; return true;
    }
    __device__ __forceinline__ void a_ready(const Unit&) const {}
    __device__ __forceinline__ void done(const Unit&) const {}
};

typedef const f32x4 (&AccRef)[2][2][4][2];
#define EPI_ROW(ai, m) (u.pm * BM + (ai) * HALF + wr * 64 + (m) * 16 + fr)
#define EPI_COL(bj) (u.pn * BM + (bj) * HALF + wc * 32 + 8 * fq)
__device__ __forceinline__ u32x4 pack8(f32x4 a, f32x4 b) { u32x4 w; w.x = pk2(a[0], a[1]); w.y = pk2(a[2], a[3]); w.z = pk2(b[0], b[1]); w.w = pk2(b[2], b[3]); return w; }
__device__ __forceinline__ void unpack8(u32x4 w, f32x4& a, f32x4& b) { a = (f32x4){bflo(w.x), bfhi(w.x), bflo(w.y), bfhi(w.y)}; b = (f32x4){bflo(w.z), bfhi(w.z), bflo(w.w), bfhi(w.w)}; }

struct EpiPlain {
    static constexpr bool PERM = true, AFTER_DRAIN = false, MIDK = false;
    bf16_t* O; int ldo; float* part; int vt, vfull;
    __device__ __forceinline__ void operator()(AccRef acc, const Unit& u, int wr, int wc, int fr, int fq) const {
        if (part && (u.pm % vt) >= vfull) { const int v = u.pm / vt, rt = u.pm % vt - vfull, ks = u.kt0 / u.nt, nrest = (vt - vfull) * BM;
#pragma unroll
            for (int ai = 0; ai < 2; ++ai)
#pragma unroll
                for (int m = 0; m < 4; ++m) { float* pr = part + ((size_t)(ks * 4 + v) * 32 * nrest + rt * BM + ai * HALF + wr * 64 + m * 16 + fr) * 8;
#pragma unroll
                    for (int bj = 0; bj < 2; ++bj) { float* q = pr + (size_t)(bj * 16 + wc * 4 + fq) * nrest * 8; *(f32x4*)q = acc[ai][bj][m][0]; *(f32x4*)(q + 4) = acc[ai][bj][m][1]; } }
            return; }
#pragma unroll
        for (int ai = 0; ai < 2; ++ai)
#pragma unroll
            for (int m = 0; m < 4; ++m) { bf16_t* rowp = O + (size_t)EPI_ROW(ai, m) * ldo;
#pragma unroll
                for (int bj = 0; bj < 2; ++bj) *(u32x4*)(rowp + EPI_COL(bj)) = pack8(acc[ai][bj][m][0], acc[ai][bj][m][1]); }
    }
};
struct EpiSwiglu {
    static constexpr bool PERM = true, AFTER_DRAIN = false, MIDK = false;
    bf16_t* H; int ldo; const float* ssq;
    __device__ __forceinline__ void operator()(AccRef acc, const Unit& u, int wr, int wc, int fr, int fq) const {
        const int col = u.pn * HALF + wc * 32 + 8 * fq;
#pragma unroll
        for (int ai = 0; ai < 2; ++ai)
#pragma unroll
            for (int m = 0; m < 4; ++m) { const int row = EPI_ROW(ai, m); const float rs = rstd_of(ssq[row]);
                f32x4 h0, h1;
#pragma unroll
                for (int e = 0; e < 4; ++e) { h0[e] = siluf_(acc[ai][0][m][0][e] * rs) * (acc[ai][1][m][0][e] * rs); h1[e] = siluf_(acc[ai][0][m][1][e] * rs) * (acc[ai][1][m][1][e] * rs); }
                *(u32x4*)(H + (size_t)row * ldo + col) = pack8(h0, h1); asm volatile("" ::: "memory"); }
    }
};
struct EpiResid {
    static constexpr bool PERM = true, AFTER_DRAIN = false, MIDK = false;
    const float* baseP; const float* baseS; float* xr; bf16_t* xb; float* ssq_out; float scale; float* part; int mode;
    __device__ __forceinline__ void operator()(AccRef acc, const Unit& u, int wr, int wc, int fr, int fq) const {
        if (part && u.pm >= NP / BM) { const int ks = u.kt0 / u.nt;
#pragma unroll
            for (int ai = 0; ai < 2; ++ai)
#pragma unroll
                for (int m = 0; m < 4; ++m) { float* pr = part + ((size_t)ks * NSR + (EPI_ROW(ai, m) - NP)) * DM;
#pragma unroll
                    for (int bj = 0; bj < 2; ++bj) { const int col = EPI_COL(bj); *(f32x4*)(pr + col) = acc[ai][bj][m][0]; *(f32x4*)(pr + col + 4) = acc[ai][bj][m][1]; } }
            return; }
#pragma unroll
        for (int ai = 0; ai < 2; ++ai)
#pragma unroll
            for (int m = 0; m < 4; ++m) { const int row = EPI_ROW(ai, m);
                const float* bp = row < NP ? baseP + (size_t)row * DM : baseS + (size_t)(row - NP) * DM; float ss = 0.f;
#pragma unroll
                for (int bj = 0; bj < 2; ++bj) { const int col = EPI_COL(bj);
                    f32x4 o0, o1; if (mode & 1) unpack8(*(const u32x4*)(xb + (size_t)row * DM + col), o0, o1); else { o0 = *(const f32x4*)(bp + col); o1 = *(const f32x4*)(bp + col + 4); }
                    const f32x4 n0 = o0 + acc[ai][bj][m][0] * scale, n1 = o1 + acc[ai][bj][m][1] * scale;
                    if (!(mode & 2) || row >= NP) { *(f32x4*)(xr + (size_t)row * DM + col) = n0; *(f32x4*)(xr + (size_t)row * DM + col + 4) = n1; }
                    *(u32x4*)(xb + (size_t)row * DM + col) = pack8(n0, n1);
                    ss += (n0[0] * n0[0] + n0[1] * n0[1]) + (n0[2] * n0[2] + n0[3] * n0[3]) + (n1[0] * n1[0] + n1[1] * n1[1]) + (n1[2] * n1[2] + n1[3] * n1[3]); }
                ss += __shfl_xor(ss, 16); ss += __shfl_xor(ss, 32);
                if (fq == 0) atomicAdd(ssq_out + row, ss); asm volatile("" ::: "memory"); }
    }
};
struct EpiWin {
    static constexpr bool PERM = true, AFTER_DRAIN = false, MIDK = false;
    const float* ssq; float* out; bf16_t *Q, *CCBP, *KVS, *KVW, *U, *MG; float* NG;
    __device__ __forceinline__ void operator()(AccRef acc, const Unit& u, int wr, int wc, int fr, int fq) const {
        const int pn = u.pn;
#pragma unroll
        for (int ai = 0; ai < 2; ++ai)
#pragma unroll
            for (int m = 0; m < 4; ++m) { const int row = EPI_ROW(ai, m); const float rs = rstd_of(ssq[row]);
#pragma unroll
                for (int bj = 0; bj < 2; ++bj) { const int c = bj * HALF + wc * 32 + 8 * fq;
                    f32x4 v0 = acc[ai][bj][m][0] * rs, v1 = acc[ai][bj][m][1] * rs;
                    if (pn < 2) { v0 = v0 * (0.125f * LOG2E); v1 = v1 * (0.125f * LOG2E); *(u32x4*)(Q + (size_t)row * 512 + pn * 256 + c) = pack8(v0, v1); }
                    else if (pn < 5) {
                        float* op; bool wr_out = true;
                        if (row < NP) { const int t = row & (SEQ - 1), b = row >> 11;
                            if (pn == 2) op = out + O_KVCP + (size_t)row * 256; else if (pn == 3) op = out + O_KVSP + (size_t)row * 256;
                            else { op = out + O_KVWP + (size_t)(b * 512 + (t - 1536)) * 256; wr_out = t >= 1536; } }
                        else { const int sr = row - NP, b = sr >> 2, s = sr & 3;
                            if (pn == 2) op = out + O_KVCS + (size_t)sr * 256; else if (pn == 3) op = out + O_KVSS + (size_t)sr * 256;
                            else op = out + O_KVWS + (size_t)(b * 512 + 508 + s) * 256; }
                        if (wr_out) { *(f32x4*)(op + c) = v0; *(f32x4*)(op + c + 4) = v1; }
                        const u32x4 w = pack8(v0, v1);
                        if (pn == 2) { if (row < NP) *(u32x4*)(CCBP + (size_t)row * 256 + c) = w; }
                        else if (pn == 3) *(u32x4*)(KVS + (size_t)row * 256 + c) = w;
                        else *(u32x4*)(KVW + (size_t)row * 256 + c) = w; }
                    else if (pn < 7) { *(u32x4*)(U + (size_t)row * 512 + (pn - 5) * 256 + c) = pack8(v0, v1); }
                    else if (pn < 15) { if (bj == 0) {
                        f32x4 s0 = acc[ai][1][m][0] * rs, s1 = acc[ai][1][m][1] * rs;
#pragma unroll
                        for (int e = 0; e < 4; ++e) { s0[e] = fmaxf(sigmoidf_(s0[e]), 1e-30f); s1[e] = fmaxf(sigmoidf_(s1[e]), 1e-30f); v0[e] = sigmoidf_(v0[e]) * fast_rcp(s0[e]); v1[e] = sigmoidf_(v1[e]) * fast_rcp(s1[e]); }
                        const int cg = (pn - 7) * 128 + wc * 32 + 8 * fq;
                        *(u32x4*)(MG + (size_t)row * 2048 + cg) = pack8(v0, v1); *(u32x4*)(MG + (size_t)row * 2048 + 1024 + cg) = pack8(s0, s1); } }
                    else { if (c < 24) {
#pragma unroll
                        for (int e = 0; e < 4; ++e) { v0[e] = sigmoidf_(v0[e]); v1[e] = sigmoidf_(v1[e]); }
                        *(f32x4*)(NG + (size_t)row * 24 + c) = v0; *(f32x4*)(NG + (size_t)row * 24 + c + 4) = v1; } }
                } asm volatile("" ::: "memory"); }
    }
};
struct EpiGlu {
    static constexpr bool PERM = true, AFTER_DRAIN = false, MIDK = false;
    const bf16_t* YG; bf16_t* AO;
    __device__ __forceinline__ void operator()(AccRef acc, const Unit& u, int wr, int wc, int fr, int fq) const {
#pragma unroll
        for (int ai = 0; ai < 2; ++ai)
#pragma unroll
            for (int m = 0; m < 4; ++m) { const int row = EPI_ROW(ai, m);
#pragma unroll
                for (int bj = 0; bj < 2; ++bj) { const int col = EPI_COL(bj); f32x4 y0, y1; unpack8(*(const u32x4*)(YG + (size_t)row * 512 + col), y0, y1);
#pragma unroll
                    for (int e = 0; e < 4; ++e) { y0[e] *= sigmoidf_(acc[ai][bj][m][0][e]); y1[e] *= sigmoidf_(acc[ai][bj][m][1][e]); }
                    *(u32x4*)(AO + (size_t)row * DM + 512 + col) = pack8(y0, y1); } asm volatile("" ::: "memory"); }
    }
};
struct EpiMerge {
    static constexpr bool PERM = true, AFTER_DRAIN = false, MIDK = true;
    const bf16_t* MG; bf16_t* TT;
    __device__ __forceinline__ void mid(f32x4 (&acc)[2][2][4][2], const Unit& u, int wr, int wc, int fr, int fq) const {
#pragma unroll
        for (int ai = 0; ai < 2; ++ai)
#pragma unroll
            for (int m = 0; m < 4; ++m) { const int row = EPI_ROW(ai, m);
#pragma unroll
                for (int bj = 0; bj < 2; ++bj) { const int col = EPI_COL(bj); f32x4 a0, a1; unpack8(*(const u32x4*)(MG + (size_t)row * 2048 + col), a0, a1);
                    acc[ai][bj][m][0] = acc[ai][bj][m][0] * a0; acc[ai][bj][m][1] = acc[ai][bj][m][1] * a1; }
                asm volatile("" ::: "memory"); }
    }
    __device__ __forceinline__ void operator()(AccRef acc, const Unit& u, int wr, int wc, int fr, int fq) const {
#pragma unroll
        for (int ai = 0; ai < 2; ++ai)
#pragma unroll
            for (int m = 0; m < 4; ++m) { const int row = EPI_ROW(ai, m);
#pragma unroll
                for (int bj = 0; bj < 2; ++bj) { const int col = EPI_COL(bj); f32x4 s0, s1; unpack8(*(const u32x4*)(MG + (size_t)row * 2048 + 1024 + col), s0, s1);
                    *(u32x4*)(TT + (size_t)row * DM + col) = pack8(s0 * acc[ai][bj][m][0], s1 * acc[ai][bj][m][1]); }
                asm volatile("" ::: "memory"); }
    }
};
struct EpiMerge1 {
    static constexpr bool PERM = true, AFTER_DRAIN = false, MIDK = false;
    const bf16_t* MG; float* T1;
    __device__ __forceinline__ void operator()(AccRef acc, const Unit& u, int wr, int wc, int fr, int fq) const {
#pragma unroll
        for (int ai = 0; ai < 2; ++ai)
#pragma unroll
            for (int m = 0; m < 4; ++m) { const int row = EPI_ROW(ai, m);
#pragma unroll
                for (int bj = 0; bj < 2; ++bj) { const int col = EPI_COL(bj); f32x4 g0, g1; unpack8(*(const u32x4*)(MG + (size_t)row * 2048 + col), g0, g1);
                    *(f32x4*)(T1 + (size_t)row * DM + col) = g0 * acc[ai][bj][m][0]; *(f32x4*)(T1 + (size_t)row * DM + col + 4) = g1 * acc[ai][bj][m][1]; } asm volatile("" ::: "memory"); }
    }
};
struct EpiMerge2 {
    static constexpr bool PERM = true, AFTER_DRAIN = false, MIDK = false;
    const bf16_t* MG; const float* T1; bf16_t* TT;
    __device__ __forceinline__ void operator()(AccRef acc, const Unit& u, int wr, int wc, int fr, int fq) const {
#pragma unroll
        for (int ai = 0; ai < 2; ++ai)
#pragma unroll
            for (int m = 0; m < 4; ++m) { const int row = EPI_ROW(ai, m);
#pragma unroll
                for (int bj = 0; bj < 2; ++bj) { const int col = EPI_COL(bj); f32x4 g0, g1; unpack8(*(const u32x4*)(MG + (size_t)row * 2048 + 1024 + col), g0, g1);
                    const f32x4 t0 = *(const f32x4*)(T1 + (size_t)row * DM + col) + g0 * acc[ai][bj][m][0], t1 = *(const f32x4*)(T1 + (size_t)row * DM + col + 4) + g1 * acc[ai][bj][m][1];
                    *(u32x4*)(TT + (size_t)row * DM + col) = pack8(t0, t1); } asm volatile("" ::: "memory"); }
    }
};
struct EpiPleGate {
    static constexpr bool PERM = true, AFTER_DRAIN = false, MIDK = false;
    const float* ssq; const bf16_t* PP; float* xr; float* ssq_out; float* part; const bf16_t* xbase; bf16_t* xout;
    __device__ __forceinline__ void operator()(AccRef acc, const Unit& u, int wr, int wc, int fr, int fq) const {
        if (part && u.pm >= NP / BM) { const int ks = u.kt0 / u.nt;
#pragma unroll
            for (int ai = 0; ai < 2; ++ai)
#pragma unroll
                for (int m = 0; m < 4; ++m) { float* pr = part + ((size_t)ks * NSR + (EPI_ROW(ai, m) - NP)) * DM;
#pragma unroll
                    for (int bj = 0; bj < 2; ++bj) { const int col = EPI_COL(bj); *(f32x4*)(pr + col) = acc[ai][bj][m][0]; *(f32x4*)(pr + col + 4) = acc[ai][bj][m][1]; } }
            return; }
#pragma unroll
        for (int ai = 0; ai < 2; ++ai)
#pragma unroll
            for (int m = 0; m < 4; ++m) { const int row = EPI_ROW(ai, m); const float rs = rstd_of(ssq[row]); float ss = 0.f;
#pragma unroll
                for (int bj = 0; bj < 2; ++bj) { const int col = EPI_COL(bj); f32x4 p0, p1; unpack8(*(const u32x4*)(PP + (size_t)row * DM + col), p0, p1);
                    f32x4 n0, n1; unpack8(*(const u32x4*)(xbase + (size_t)row * DM + col), n0, n1);
#pragma unroll
                    for (int e = 0; e < 4; ++e) { n0[e] += sigmoidf_(acc[ai][bj][m][0][e] * rs) * p0[e]; n1[e] += sigmoidf_(acc[ai][bj][m][1][e] * rs) * p1[e]; }
                    *(u32x4*)(xout + (size_t)row * DM + col) = pack8(n0, n1);
                    ss += (n0[0] * n0[0] + n0[1] * n0[1]) + (n0[2] * n0[2] + n0[3] * n0[3]) + (n1[0] * n1[0] + n1[1] * n1[1]) + (n1[2] * n1[2] + n1[3] * n1[3]); }
                ss += __shfl_xor(ss, 16); ss += __shfl_xor(ss, 32);
                if (fq == 0) atomicAdd(ssq_out + row, ss); asm volatile("" ::: "memory"); }
    }
};
template <class Epi, class Sched, bool ALIGN_EPI = false, bool SP2 = false>
__device__ __forceinline__ void gemm_phase(PG8_LAS unsigned char* lds, const Gemm g, const Sched& S, const Epi& E) {
    const int tid = threadIdx.x, wid = __builtin_amdgcn_readfirstlane(tid >> 6), lane = tid & 63, wr = wid >> 2, wc = wid & 3, fr = lane & 15, fq = lane >> 4;
    const int K = g.K;
    unsigned voffA[2], voffB[2];
#pragma unroll
    for (int i = 0; i < 2; ++i) { int R, C; stage_rc(tid * 16 + i * 8192, R, C); const int Rb = Epi::PERM ? ((R & ~31) + perm32(R & 31)) : R;
        voffA[i] = (unsigned)(R * g.lda + C) * 2u; voffB[i] = (unsigned)(Rb * K + C) * 2u; }
    const size_t kstep = (size_t)(BK * 2), kstepA = (size_t)g.kstepA * 2;
    const size_t hstep = (size_t)HALF * K * 2, hstepA = (size_t)HALF * g.lda * 2;
        const unsigned ldsw = (unsigned)wid * 1024u;
    const int aoff = lds_byte(wr * 64 + fr, fq * 8), boff = lds_byte(wc * 32 + fr, fq * 8);
#define PG8_SA(b, h) (((b) * 2 + (h)) * HTB)
#define PG8_SB(b, h) ((4 + (b) * 2 + (h)) * HTB)
#define PG8_STAGE(bufoff, gbase, voff) do { _Pragma("unroll") for (int _i = 0; _i < 2; ++_i) \
        __builtin_amdgcn_global_load_lds((const unsigned*)((const char*)(gbase) + (voff)[_i]), (PG8_LAS unsigned*)(lds + (bufoff) + ldsw + _i * 8192), 16, 0, 0); } while (0)
#define PG8_LDA(dst, b, h) do { _Pragma("unroll") for (int m = 0; m < 4; ++m) _Pragma("unroll") for (int k = 0; k < 2; ++k) dst[m][k] = *(const PG8_LAS bf16x8*)(lds + PG8_SA(b, h) + aoff + m * 2048 + k * 1024); } while (0)
#define PG8_LDB(dst, b, h) do { _Pragma("unroll") for (int n = 0; n < 2; ++n) _Pragma("unroll") for (int k = 0; k < 2; ++k) dst[n][k] = *(const PG8_LAS bf16x8*)(lds + PG8_SB(b, h) + boff + n * 2048 + k * 1024); } while (0)
#define PG8_MMA(ai, bj, At, Bt) do { __builtin_amdgcn_s_setprio(1); _Pragma("unroll") for (int m = 0; m < 4; ++m) _Pragma("unroll") for (int n = 0; n < 2; ++n) _Pragma("unroll") for (int k = 0; k < 2; ++k) \
        acc[ai][bj][m][n] = __builtin_amdgcn_mfma_f32_16x16x32_bf16(Bt[n][k], At[m][k], acc[ai][bj][m][n], 0, 0, 0); __builtin_amdgcn_s_setprio(0); } while (0)
#define PG8_WAIT_V(n) asm volatile("s_waitcnt vmcnt(" #n ")" ::: "memory")
#define PG8_WAIT_L(n) asm volatile("s_waitcnt lgkmcnt(" #n ")" ::: "memory")
#define PG8_BAR __builtin_amdgcn_s_barrier()
#define PG8_SCHED __builtin_amdgcn_sched_barrier(0)
    Unit cur, nxt; int ui = 0;
    if (!S.next(0, cur)) return;
    f32x4 acc[2][2][4][2];
#pragma unroll
    for (int a = 0; a < 2; ++a)
#pragma unroll
        for (int b = 0; b < 2; ++b)
#pragma unroll
            for (int m = 0; m < 4; ++m)
#pragma unroll
                for (int n = 0; n < 2; ++n) acc[a][b][m][n] = (f32x4){0.f, 0.f, 0.f, 0.f};
    bf16x8 At[4][2], B0[2][2], B1[2][2];
    const char* cA = g.a_tile(cur); const char* cB = g.b_tile(cur);
    S.a_ready(cur);
    if constexpr (SP2) {
        PG8_STAGE(PG8_SB(0, 0), cB, voffB); PG8_STAGE(PG8_SB(0, 1), cB + hstep, voffB); PG8_STAGE(PG8_SA(0, 0), cA, voffA); PG8_STAGE(PG8_SA(0, 1), cA + hstepA, voffA);
        if (wr == 1) PG8_BAR;
        PG8_WAIT_V(2); PG8_BAR;
        PG8_STAGE(PG8_SB(1, 0), cB + kstep, voffB); PG8_STAGE(PG8_SA(1, 0), cA + kstepA, voffA); PG8_STAGE(PG8_SB(1, 1), cB + hstep + kstep, voffB);
        PG8_WAIT_V(6); PG8_BAR;
    } else {
        PG8_STAGE(PG8_SB(0, 0), cB, voffB); PG8_STAGE(PG8_SA(0, 0), cA, voffA); PG8_STAGE(PG8_SB(0, 1), cB + hstep, voffB); PG8_STAGE(PG8_SA(0, 1), cA + hstepA, voffA);
        if (wr == 1) PG8_BAR;
        PG8_WAIT_V(4); PG8_BAR;
        PG8_STAGE(PG8_SB(1, 0), cB + kstep, voffB); PG8_STAGE(PG8_SA(1, 0), cA + kstepA, voffA); PG8_STAGE(PG8_SB(1, 1), cB + hstep + kstep, voffB);
        PG8_WAIT_V(6); PG8_BAR;
    }
    for (;;) {
        const bool has_next = S.next(ui + 1, nxt);
        const char* nA = has_next ? g.a_tile(nxt) : cA; const char* nB = has_next ? g.b_tile(nxt) : cB;
        const int nt = cur.nt;
        for (int t = 0; t < nt; t += 2) {
            const bool last = (t == nt - 2);
            const char* a1 = cA + (size_t)(t + 1) * kstepA;
            const char* a2 = last ? nA : cA + (size_t)(t + 2) * kstepA; const char* b2 = last ? nB : cB + (size_t)(t + 2) * kstep;
            const char* a3 = a2 + kstepA; const char* b3 = b2 + kstep;
            if (last && has_next) S.a_ready(nxt);
            if constexpr (Epi::MIDK) { if (t == (nt >> 1)) E.mid(acc, cur, wr, wc, fr, fq); }
            if constexpr (SP2) {
            PG8_LDB(B0, 0, 0); PG8_LDB(B1, 0, 1); PG8_SCHED; PG8_LDA(At, 0, 0); PG8_STAGE(PG8_SA(1, 1), a1 + hstepA, voffA);
            PG8_WAIT_V(8); PG8_WAIT_L(0); PG8_BAR; PG8_MMA(0, 0, At, B0); PG8_MMA(0, 1, At, B1); PG8_BAR; PG8_SCHED;
            PG8_LDA(At, 0, 1); PG8_STAGE(PG8_SB(0, 0), b2, voffB); PG8_STAGE(PG8_SB(0, 1), b2 + hstep, voffB); PG8_STAGE(PG8_SA(0, 0), a2, voffA);
            PG8_WAIT_V(8); PG8_WAIT_L(0); PG8_BAR; PG8_MMA(1, 0, At, B0); PG8_MMA(1, 1, At, B1); PG8_BAR; PG8_SCHED;
            PG8_LDB(B0, 1, 0); PG8_LDB(B1, 1, 1); PG8_SCHED; PG8_LDA(At, 1, 0); PG8_STAGE(PG8_SA(0, 1), a2 + hstepA, voffA);
            PG8_WAIT_V(8); PG8_WAIT_L(0); PG8_BAR; PG8_MMA(0, 0, At, B0); PG8_MMA(0, 1, At, B1); PG8_BAR; PG8_SCHED;
            PG8_LDA(At, 1, 1); PG8_STAGE(PG8_SB(1, 0), b3, voffB); PG8_STAGE(PG8_SB(1, 1), b3 + hstep, voffB); PG8_STAGE(PG8_SA(1, 0), a3, voffA);
            PG8_WAIT_V(8); PG8_WAIT_L(0); PG8_BAR; PG8_MMA(1, 0, At, B0); PG8_MMA(1, 1, At, B1); PG8_BAR; PG8_SCHED;
            } else {
            PG8_LDB(B0, 0, 0); PG8_SCHED; PG8_LDA(At, 0, 0); PG8_STAGE(PG8_SA(1, 1), a1 + hstepA, voffA);
            PG8_WAIT_L(8); PG8_BAR; PG8_WAIT_L(0); PG8_MMA(0, 0, At, B0); PG8_BAR; PG8_SCHED;
            PG8_LDB(B1, 0, 1); PG8_STAGE(PG8_SB(0, 0), b2, voffB);
            PG8_BAR; PG8_WAIT_L(0); PG8_MMA(0, 1, At, B1); PG8_BAR;
            PG8_LDA(At, 0, 1); PG8_STAGE(PG8_SA(0, 0), a2, voffA);
            PG8_BAR; PG8_WAIT_L(0); PG8_MMA(1, 0, At, B0); PG8_BAR; PG8_SCHED;
            PG8_STAGE(PG8_SB(0, 1), b2 + hstep, voffB);
            PG8_WAIT_V(6); PG8_BAR; PG8_MMA(1, 1, At, B1); PG8_BAR;
            PG8_LDB(B0, 1, 0); PG8_SCHED; PG8_LDA(At, 1, 0); PG8_STAGE(PG8_SA(0, 1), a2 + hstepA, voffA);
            PG8_WAIT_L(8); PG8_BAR; PG8_WAIT_L(0); PG8_MMA(0, 0, At, B0); PG8_BAR; PG8_SCHED;
            PG8_LDB(B1, 1, 1); PG8_STAGE(PG8_SB(1, 0), b3, voffB);
            PG8_BAR; PG8_WAIT_L(0); PG8_MMA(0, 1, At, B1); PG8_BAR;
            PG8_LDA(At, 1, 1); PG8_STAGE(PG8_SA(1, 0), a3, voffA);
            PG8_BAR; PG8_WAIT_L(0); PG8_MMA(1, 0, At, B0); PG8_BAR; PG8_SCHED;
            PG8_STAGE(PG8_SB(1, 1), b3 + hstep, voffB);
            PG8_WAIT_V(6); PG8_BAR; PG8_MMA(1, 1, At, B1); PG8_BAR;
            }
        }
        if constexpr (ALIGN_EPI) { if (wr == 0) PG8_BAR; }
        if constexpr (!Epi::AFTER_DRAIN) { E(acc, cur, wr, wc, fr, fq); S.done(cur); }
        if (!has_next) break;
#pragma unroll
        for (int a = 0; a < 2; ++a)
#pragma unroll
            for (int b = 0; b < 2; ++b)
#pragma unroll
                for (int m = 0; m < 4; ++m)
#pragma unroll
                    for (int n = 0; n < 2; ++n) acc[a][b][m][n] = (f32x4){0.f, 0.f, 0.f, 0.f};
        cur = nxt; cA = nA; cB = nB; ++ui;
        if constexpr (ALIGN_EPI) { if (wr == 1) PG8_BAR; }
    }
    PG8_WAIT_V(0);
    if constexpr (!ALIGN_EPI) { if (wr == 0) PG8_BAR; }
    PG8_BAR;
    if constexpr (Epi::AFTER_DRAIN) { E.fused(acc, cur, wr, wc, fr, fq, lds, wid, lane); S.done(cur); }
#undef PG8_SA
#undef PG8_SB
#undef PG8_STAGE
#undef PG8_LDA
#undef PG8_LDB
#undef PG8_MMA
#undef PG8_WAIT_V
#undef PG8_WAIT_L
#undef PG8_BAR
#undef PG8_SCHED
}
}
struct Params {
    const float* in[45];
    float* out; unsigned char* ws;
    int ph_lo, ph_hi, coop, pad;
    unsigned char bucket[128];
};
enum InIdx { I_XP = 0, I_XS, I_CKC, I_CKS, I_SKW, I_SRE, I_SIM, I_PT, I_PP, I_PS, I_RELB, I_G1, I_W1G, I_W1U, I_W1D, I_GMIX, I_WIN, I_CPK, I_CW1K, I_CB1K, I_CW2K, I_CPV, I_CW1V, I_CB1V, I_CW2V,
             I_LRE, I_LIM, I_LDT, I_BRE, I_BIM, I_CRE, I_CIM, I_SD, I_WGLU, I_WBA, I_WBS, I_WOUT, I_G2, I_W2G, I_W2U, I_W2D, I_GPLE, I_WPG, I_WPP, I_GFIN };

struct Frame { LAS unsigned char* lds; int tid, lane, wave, G, vcu; };
__device__ __forceinline__ Frame launder(Frame F) { asm volatile("" : "+v"(F.tid)); F.lane = F.tid & 63; F.wave = __builtin_amdgcn_readfirstlane(F.tid >> 6); int g = F.G, v = F.vcu; asm volatile("" : "+s"(g), "+s"(v)); F.G = g; F.vcu = v; return F; }
__device__ __forceinline__ float wave_sum(float v) {
#pragma unroll
    for (int o = 1; o < 64; o <<= 1) v += __shfl_xor(v, o);
    return v;
}

__device__ __forceinline__ void transpose_item(const float* W, int N, bf16* WT, int KT, int k0, int drow0, int scol0, int nvalid, const float* gk, LAS float* scr, int lane) {
    { const int c4 = (lane & 7) * 4; f32x4 v[8];
#pragma unroll
      for (int i = 0; i < 8; ++i) { const int kk = 8 * i + (lane >> 3); v[i] = (f32x4){0.f, 0.f, 0.f, 0.f};
          if (c4 < nvalid) { v[i] = *(const f32x4*)(W + (size_t)(k0 + kk) * N + scol0 + c4); if (gk) v[i] = v[i] * gk[k0 + kk]; } }
#pragma unroll
      for (int i = 0; i < 8; ++i) { const int kk = 8 * i + (lane >> 3); LAS float* d = scr + kk * 33 + c4; d[0] = v[i][0]; d[1] = v[i][1]; d[2] = v[i][2]; d[3] = v[i][3]; } }
    LDS_WAIT();
    const int c8 = lane & 7;
#pragma unroll
    for (int j = 0; j < 4; ++j) { const int n = (lane >> 3) + 8 * j; const LAS float* s = scr + (8 * c8) * 33 + n;
        u32x4 o; o.x = pk2(s[0 * 33], s[1 * 33]); o.y = pk2(s[2 * 33], s[3 * 33]); o.z = pk2(s[4 * 33], s[5 * 33]); o.w = pk2(s[6 * 33], s[7 * 33]);
        *(u32x4*)(WT + (size_t)(drow0 + n) * KT + k0 + 8 * c8) = o; }
    LDS_WAIT();
}
__device__ __forceinline__ void row256_to_bf16(const float* src, bf16* dst, int lane) {
    const f32x4 v = *(const f32x4*)(src + 4 * lane); u32x2 w; w.x = pk2(v[0], v[1]); w.y = pk2(v[2], v[3]); *(u32x2*)(dst + 4 * lane) = w;
}

__device__ __forceinline__ void ssm_tables_item(const Params& P, LAS float* L, int item, int tid) {
    const int g = item >> 3, q = item & 7;
    LAS float* apw = L;
    LAS float* bbl = L + 33 * 128;
    LAS float* ccl = bbl + 2048;
    LAS float* krn = ccl + 2048;
    unsigned char* ws = P.ws;
    if (tid < 64) { const int p = tid;
        const float dt = expf(P.in[I_LDT][g]), lr = P.in[I_LRE][g * 64 + p], li = P.in[I_LIM][g * 64 + p];
        const float mag = expf(lr * dt), ang = li * dt, ar = mag * cosf(ang), ai = mag * sinf(ang);
        const float den = lr * lr + li * li, fr = ((ar - 1.0f) * lr + ai * li) / den, fi = (ai * lr - (ar - 1.0f) * li) / den;
        float pr = 1.f, pi = 0.f;
        for (int k = 0; k <= 32; ++k) { apw[(k * 64 + p) * 2] = pr; apw[(k * 64 + p) * 2 + 1] = pi; const float nr = pr * ar - pi * ai, ni = pr * ai + pi * ar; pr = nr; pi = ni; }
        for (int c = 0; c < 16; ++c) { const float br = P.in[I_BRE][(g * 64 + p) * 16 + c], bi = P.in[I_BIM][(g * 64 + p) * 16 + c];
            const float xr = fr * br - fi * bi, xi = fr * bi + fi * br; bbl[(p * 16 + c) * 2] = xr; bbl[(p * 16 + c) * 2 + 1] = xi;
            if (q == 0) { ((float*)(ws + WS_BBT))[((g * 64 + p) * 16 + c) * 2] = xr; ((float*)(ws + WS_BBT))[((g * 64 + p) * 16 + c) * 2 + 1] = xi; } }
        if (q == 0) { ((float*)(ws + WS_ABT))[(g * 64 + p) * 2] = ar; ((float*)(ws + WS_ABT))[(g * 64 + p) * 2 + 1] = ai; }
    }
    for (int e = tid; e < 1024; e += NTHREADS) { const int c = e >> 6, p = e & 63; ccl[e * 2] = P.in[I_CRE][(g * 16 + c) * 64 + p]; ccl[e * 2 + 1] = P.in[I_CIM][(g * 16 + c) * 64 + p]; }
    __syncthreads();
    if (q == 0 && tid < 64) { ((float*)(ws + WS_ABL))[(g * 64 + tid) * 2] = apw[(32 * 64 + tid) * 2]; ((float*)(ws + WS_ABL))[(g * 64 + tid) * 2 + 1] = apw[(32 * 64 + tid) * 2 + 1]; }
    for (int o = tid; o < 1024; o += NTHREADS) { const int k = o >> 8, c = (o >> 4) & 15, c2 = o & 15, lag = q + 8 * k; float s = 0.f;
        for (int p = 0; p < 64; ++p) { const float ar = apw[(lag * 64 + p) * 2], ai = apw[(lag * 64 + p) * 2 + 1], br = bbl[(p * 16 + c2) * 2], bi = bbl[(p * 16 + c2) * 2 + 1];
            const float tr = ar * br - ai * bi, ti = ar * bi + ai * br; s += ccl[(c * 64 + p) * 2] * tr - ccl[(c * 64 + p) * 2 + 1] * ti; }
        krn[o] = s; }
    __syncthreads();
    bf16* TZ = (bf16*)(ws + WS_TZ) + (size_t)g * 512 * 512;
    for (int e = tid; e < 2048; e += NTHREADS) { const int k = e >> 9, j = (e >> 4) & 31, c = e & 15, lag = q + 8 * k;
        if (j >= lag) { const int i = j - lag; const LAS float* kp = krn + k * 256 + c * 16; u32x4 w0, w1;
            w0.x = pk2(kp[0], kp[1]); w0.y = pk2(kp[2], kp[3]); w0.z = pk2(kp[4], kp[5]); w0.w = pk2(kp[6], kp[7]); w1.x = pk2(kp[8], kp[9]); w1.y = pk2(kp[10], kp[11]); w1.z = pk2(kp[12], kp[13]); w1.w = pk2(kp[14], kp[15]);
            bf16* d = TZ + (size_t)(j * 16 + c) * 512 + i * 16; *(u32x4*)d = w0; *(u32x4*)(d + 8) = w1; } }
    { const int rr = tid >> 3, seg = tid & 7, j = q + 8 * (rr >> 4), c = rr & 15; bf16* d = TZ + (size_t)(j * 16 + c) * 512;
#pragma unroll
      for (int r4 = 0; r4 < 4; ++r4) { const int col = 64 * seg + 16 * r4; if (col >= (j + 1) * 16) { *(u32x4*)(d + col) = (u32x4){0u, 0u, 0u, 0u}; *(u32x4*)(d + col + 8) = (u32x4){0u, 0u, 0u, 0u}; } } }
    { const int n = 16 * q + (tid >> 5), i = tid & 31, p = n & 63, im = n >> 6; const float ar = apw[((31 - i) * 64 + p) * 2], ai = apw[((31 - i) * 64 + p) * 2 + 1]; float v[16];
#pragma unroll
      for (int c = 0; c < 16; ++c) { const float br = bbl[(p * 16 + c) * 2], bi = bbl[(p * 16 + c) * 2 + 1]; v[c] = im ? (ar * bi + ai * br) : (ar * br - ai * bi); }
      bf16* d = (bf16*)(ws + WS_PT) + ((size_t)g * 128 + n) * 512 + i * 16; u32x4 w0, w1;
      w0.x = pk2(v[0], v[1]); w0.y = pk2(v[2], v[3]); w0.z = pk2(v[4], v[5]); w0.w = pk2(v[6], v[7]); w1.x = pk2(v[8], v[9]); w1.y = pk2(v[10], v[11]); w1.z = pk2(v[12], v[13]); w1.w = pk2(v[14], v[15]);
      *(u32x4*)d = w0; *(u32x4*)(d + 8) = w1; }
    { const int row = 64 * q + (tid >> 3), n0 = (tid & 7) * 16, j = row >> 4, c = row & 15; float v[16];
#pragma unroll
      for (int e = 0; e < 16; ++e) { const int n = n0 + e, p = n & 63; const float ar = apw[((j + 1) * 64 + p) * 2], ai = apw[((j + 1) * 64 + p) * 2 + 1], cr = ccl[(c * 64 + p) * 2], ci = ccl[(c * 64 + p) * 2 + 1];
          v[e] = (n0 < 64) ? (cr * ar - ci * ai) : -(cr * ai + ci * ar); }
      bf16* d = (bf16*)(ws + WS_WC) + ((size_t)g * 512 + row) * 128 + n0; u32x4 w0, w1;
      w0.x = pk2(v[0], v[1]); w0.y = pk2(v[2], v[3]); w0.z = pk2(v[4], v[5]); w0.w = pk2(v[6], v[7]); w1.x = pk2(v[8], v[9]); w1.y = pk2(v[10], v[11]); w1.z = pk2(v[12], v[13]); w1.w = pk2(v[14], v[15]);
      *(u32x4*)d = w0; *(u32x4*)(d + 8) = w1; }
    __syncthreads();
}

__device__ __forceinline__ void transpose_jobs(const Params& P, unsigned jobmask, int gw, int NGW, LAS float* scr, int lane);
template <int PARTS> __device__ __forceinline__ void background_copy(const Params& P, int gw, int NGW, int lane, LAS float* scr) {
    unsigned char* ws = P.ws;
    if (PARTS & 3) transpose_jobs(P, ((PARTS & 1) ? 0x0038u : 0u) | ((PARTS & 2) ? 0x07C0u : 0u), gw, NGW, scr, lane);
    if (PARTS & 4) { bf16* PB = (bf16*)(ws + WS_PB);
      for (int m0 = gw * 4; m0 < MR; m0 += NGW * 4) { f32x4 v[4];
#pragma unroll
          for (int i = 0; i < 4; ++i) { const int m = m0 + i; v[i] = *(const f32x4*)((m < NP ? P.in[I_PP] + (size_t)m * PLE : P.in[I_PS] + (size_t)(m - NP) * PLE) + 4 * lane); }
#pragma unroll
          for (int i = 0; i < 4; ++i) { u32x2 w; w.x = pk2(v[i][0], v[i][1]); w.y = pk2(v[i][2], v[i][3]); *(u32x2*)(PB + (size_t)(m0 + i) * PLE + 4 * lane) = w; } } }
    if (PARTS & 8) { bf16* CCB = (bf16*)(ws + WS_CCB); const int* pt = (const int*)P.in[I_PT];
      for (int r0 = gw * 16; r0 < DB * PAST; r0 += NGW * 16) { const int b = r0 >> 11, pos0 = r0 & 2047; const int page = pt[b * 16 + (pos0 >> 7)];
          const float* src = P.in[I_CKC] + ((size_t)page * 128 + (pos0 & 127)) * 256 + 4 * lane; f32x4 v[16];
#pragma unroll
          for (int i = 0; i < 16; ++i) v[i] = __builtin_nontemporal_load((const f32x4*)(src + (size_t)i * 256));
#pragma unroll
          for (int i = 0; i < 16; ++i) { u32x2 w; w.x = pk2(v[i][0], v[i][1]); w.y = pk2(v[i][2], v[i][3]); *(u32x2*)(CCB + (size_t)(r0 + i) * 256 + 4 * lane) = w; } } }
    if (PARTS & 48) { float* o = P.out + O_KVWS; constexpr int RLO = (PARTS & 16) ? 0 : (DB / 2) * 508, RHI = (PARTS & 32) ? DB * 508 : (DB / 2) * 508;
      for (int r0 = RLO + gw * 4; r0 < RHI; r0 += NGW * 16) { f32x4 v[16];
#pragma unroll
          for (int q = 0; q < 4; ++q) { const int r = r0 + q * NGW * 4; if (r < RHI) { const int b = r / 508, i0 = r % 508;
#pragma unroll
              for (int i = 0; i < 4; ++i) v[q * 4 + i] = __builtin_nontemporal_load((const f32x4*)(P.in[I_SKW] + ((size_t)b * 512 + i0 + i + 4) * 256 + 4 * lane)); } }
#pragma unroll
          for (int q = 0; q < 4; ++q) { const int r = r0 + q * NGW * 4; if (r < RHI) { const int b = r / 508, i0 = r % 508;
#pragma unroll
              for (int i = 0; i < 4; ++i) *(f32x4*)(o + ((size_t)b * 512 + i0 + i) * 256 + 4 * lane) = v[q * 4 + i]; } } } }
}
struct TJob { int src; int K, N, ndest, kind, gk; size_t wt; int ktot; };
__constant__ const TJob g_jobs[13] = {
        {I_W1G, DM, FF, 2 * FF, 1, I_G1, WS_WGU1, DM}, {I_W1D, FF, DM, DM, 0, -1, WS_WD1, FF}, {I_WIN, DM, 3864, NIN, 2, I_GMIX, WS_WIN, DM}, {I_WGLU, 512, 512, 512, 0, -1, WS_WGLU, 512},
        {I_WBA, 512, DM, DM, 0, -1, WS_WBA, 1024}, {I_WBS, 512, DM, DM, 0, -1, WS_WBA + 1024, 1024}, {I_WOUT, DM, DM, DM, 0, -1, WS_WOUT, DM}, {I_W2G, DM, FF, 2 * FF, 1, I_G2, WS_WGU2, DM},
        {I_W2D, FF, DM, DM, 0, -1, WS_WD2, FF}, {I_WPG, DM, DM, DM, 0, I_GPLE, WS_WPG, DM}, {I_WPP, PLE, DM, DM, 0, -1, WS_WPP, PLE}, {I_CW1K, 1024, 128, 512, 3, -1, WS_WC1, 1024}, {I_CW2K, 128, 64, 128, 4, -1, WS_WC2, 128} };
__device__ __forceinline__ void transpose_job_item(const Params& P, const TJob& J, int it, LAS float* scr, int lane) {
    unsigned char* ws = P.ws; const int nnb = J.ndest / 32;
    const int kb = it / nnb, nb = it % nnb, k0 = 64 * kb, d0 = 32 * nb; const float* W = P.in[J.src]; int scol0 = d0, nvalid = 32, N = J.N; bf16* WT = (bf16*)(ws + J.wt);
    if (J.kind == 1) { const int tile = d0 >> 8, within = d0 & 255; if (within >= 128) W = P.in[J.src + 1]; scol0 = tile * 128 + (within & 127); }
    else if (J.kind == 2) { if (d0 < 1280) scol0 = d0; else if (d0 < 1792) scol0 = d0 + 24; else if (d0 < 3840) { const int tile = (d0 - 1792) >> 8, within = (d0 - 1792) & 255; scol0 = 1816 + (within >= 128 ? 1024 : 0) + tile * 128 + (within & 127); } else if (d0 == 3840) { scol0 = 1280; nvalid = 24; } else nvalid = 0; }
    else if (J.kind == 3) { const int type = d0 >> 8, within = d0 & 255; W = P.in[type ? I_CW1V : I_CW1K]; if (within >= 128) W += (size_t)1024 * 128; scol0 = within & 127; }
    else if (J.kind == 4) { const int type = d0 >> 6; W = P.in[type ? I_CW2V : I_CW2K]; scol0 = d0 & 63; }
    transpose_item(W, N, WT, J.ktot, k0, d0, scol0, nvalid, J.gk >= 0 ? P.in[J.gk] : nullptr, scr, lane);
}
__device__ __forceinline__ void transpose_jobs(const Params& P, unsigned jobmask, int gw, int NGW, LAS float* scr, int lane) {
    int base = 0;
#pragma unroll 1
    for (int jb = 0; jb < 13; ++jb) { if (!((jobmask >> jb) & 1u)) continue; const TJob J = g_jobs[jb]; const int nit = (J.K / 64) * (J.ndest / 32);
        for (int it = gw - base % NGW; it < nit; it += NGW) { if (it < 0) continue; transpose_job_item(P, J, it, scr, lane); }
        base += nit; }
}
__device__ __forceinline__ void prologue(const Params& P, const Frame& F) {
    unsigned char* ws = P.ws;
    LAS float* scr = (LAS float*)(F.lds + F.wave * 16384);
    const int gw = F.vcu * NWAVES + F.wave, NGW = F.G * NWAVES, lane = F.lane;
    transpose_jobs(P, 0x1807, gw, NGW, scr, lane);
    { bf16* XB = (bf16*)(ws + WS_XB); float* ssq0 = (float*)(ws + WS_SSQ0);
      for (int m0 = gw * 3; m0 < MR; m0 += NGW * 3) { f32x4 v[3][4];
#pragma unroll
          for (int i = 0; i < 3; ++i) { const int m = m0 + i; const float* xr = m < NP ? P.in[I_XP] + (size_t)m * DM : P.in[I_XS] + (size_t)(m - NP) * DM;
#pragma unroll
              for (int j = 0; j < 4; ++j) v[i][j] = *(const f32x4*)(xr + 256 * j + 4 * lane); }
#pragma unroll
          for (int i = 0; i < 3; ++i) { const int m = m0 + i; float s = 0.f;
#pragma unroll
              for (int j = 0; j < 4; ++j) { s += (v[i][j][0] * v[i][j][0] + v[i][j][1] * v[i][j][1]) + (v[i][j][2] * v[i][j][2] + v[i][j][3] * v[i][j][3]);
                  u32x2 w; w.x = pk2(v[i][j][0], v[i][j][1]); w.y = pk2(v[i][j][2], v[i][j][3]); *(u32x2*)(XB + (size_t)m * DM + 256 * j + 4 * lane) = w; }
              s = wave_sum(s); if (lane == 0) ssq0[m] = s; } } }
    { float* cc = (float*)(ws + WS_CCON);
      for (int it = gw; it < 128; it += NGW) { const int type = it >> 6, nh = (it >> 5) & 1, kc = it & 31, n = nh * 64 + lane; const float* pos = P.in[type ? I_CPV : I_CPK] + kc * 64; const float* w1 = P.in[type ? I_CW1V : I_CW1K] + (size_t)kc * 64 * 128 + n;
          float s = kc == 0 ? P.in[type ? I_CB1V : I_CB1K][n] : 0.f;
#pragma unroll 16
          for (int k = 0; k < 64; ++k) s += pos[k] * w1[(size_t)k * 128];
          atomicAdd(cc + type * 128 + n, s); } }
    if (blockIdx.x == 0) { float* bt = (float*)(ws + WS_BIAS);
      for (int e = F.tid; e < 8 * 136; e += NTHREADS) { const int h = e / 136, n = e % 136; const int bk = n < 128 ? (int)P.bucket[n] : 31; bt[e] = P.in[I_RELB][bk * 8 + h] * LOG2E; } }
}
namespace att {
constexpr int SLOTB = 8192;
constexpr int L_K = 0, L_V = 2 * SLOTB, L_WS = 4 * SLOTB, L_IMP = L_WS + 2048, L_SEL = L_IMP + 4 * 64 * 33 * 4, L_UNI = L_SEL + 512, L_BT = L_UNI + 16, L_RES = L_BT + 8 * 136 * 4, L_END = L_RES + 8 * 8192;
typedef short v4i16_t __attribute__((ext_vector_type(4)));
__device__ __forceinline__ int crow(int r, int hi) { return (r & 3) + 8 * (r >> 2) + 4 * hi; }
__device__ __forceinline__ void swap_halves(float v, float& r0, float& r1) { float a = v, b = v;
    asm volatile("s_nop 1\n\tv_permlane32_swap_b32 %0, %1\n\ts_nop 1" : "+v"(a), "+v"(b)); r0 = a; r1 = b; }
__device__ __forceinline__ float other_half(float v, int hi) { float r0, r1; swap_halves(v, r0, r1); return hi ? r0 : r1; }
__device__ __forceinline__ float max_halves(float v) { float r0, r1; swap_halves(v, r0, r1); return fmaxf(r0, r1); }
__device__ __forceinline__ float sum_halves(float v) { float r0, r1; swap_halves(v, r0, r1); return r0 + r1; }

__device__ __forceinline__ void qkt(f32x16& p0, f32x16& p1, const LAS char* Ks, const bf16x8* qr, int r32, int hi, float cinit = 0.f) {
    const LAS char* kb = Ks + hi * 1024 + r32 * 16;
#pragma unroll
    for (int r = 0; r < 16; ++r) { p0[r] = cinit; p1[r] = cinit; }
#pragma unroll
    for (int d0 = 0; d0 < 4; ++d0) { const bf16x8 b0 = *(const LAS bf16x8*)(kb + d0 * 2048), b1 = *(const LAS bf16x8*)(kb + d0 * 2048 + 512);
        p0 = __builtin_amdgcn_mfma_f32_32x32x16_bf16(b0, qr[d0], p0, 0, 0, 0); p1 = __builtin_amdgcn_mfma_f32_32x32x16_bf16(b1, qr[d0], p1, 0, 0, 0); }
}
__device__ __forceinline__ s16x4 vtr(const LAS char* p) { return __builtin_bit_cast(s16x4, __builtin_amdgcn_ds_read_tr16_b64_v4i16((LAS v4i16_t*)p)); }
__device__ __forceinline__ void pv(f32x16* o, const LAS char* Vs, const bf16x8* pa, int lane, int hi) {
    const LAS char* vp = Vs + ((lane >> 4) & 1) * 32 + (lane & 3) * 8 + (4 * hi + ((lane & 15) >> 2)) * 64;
#pragma unroll
    for (int d0 = 0; d0 < 2; ++d0)
#pragma unroll
        for (int ks = 0; ks < 4; ++ks) { const s16x4 lo = vtr(vp + d0 * 4096 + ks * 1024), hh = vtr(vp + d0 * 4096 + ks * 1024 + 512);
            const bf16x8 vf = (bf16x8){lo[0], lo[1], lo[2], lo[3], hh[0], hh[1], hh[2], hh[3]};
            o[d0] = __builtin_amdgcn_mfma_f32_32x32x16_bf16(pa[ks], vf, o[d0], 0, 0, 0); }
}
__device__ __forceinline__ void pack_p(bf16x8* pa, const f32x16& p0, const f32x16& p1) {
#pragma unroll
    for (int k = 0; k < 2; ++k) { u32x4 w, x;
        w.x = pk2(p0[8 * k], p0[8 * k + 1]); w.y = pk2(p0[8 * k + 2], p0[8 * k + 3]); w.z = pk2(p0[8 * k + 4], p0[8 * k + 5]); w.w = pk2(p0[8 * k + 6], p0[8 * k + 7]);
        x.x = pk2(p1[8 * k], p1[8 * k + 1]); x.y = pk2(p1[8 * k + 2], p1[8 * k + 3]); x.z = pk2(p1[8 * k + 4], p1[8 * k + 5]); x.w = pk2(p1[8 * k + 6], p1[8 * k + 7]);
        pa[k] = __builtin_bit_cast(bf16x8, w); pa[2 + k] = __builtin_bit_cast(bf16x8, x); }
}
template <bool NEAR> __device__ __forceinline__ void mask_bias(f32x16& p0, f32x16& p1, int tq, int kbase, int kstride, int maxdist, bool rowok, const LAS float* btl, float bfar, int hi) {
#pragma unroll
    for (int r = 0; r < 16; ++r) { const int kl = crow(r, hi); const int d0 = tq - (kbase + kl * kstride), d1 = d0 - 32 * kstride;
        const bool v0 = rowok && d0 >= 0 && d0 <= maxdist, v1 = rowok && d1 >= 0 && d1 <= maxdist;
        float b0 = bfar, b1 = bfar;
        if (NEAR) { b0 = btl[min(max(d0, 0), 128)]; b1 = btl[min(max(d1, 0), 128)]; }
        p0[r] = v0 ? p0[r] + b0 : -INFINITY; p1[r] = v1 ? p1[r] + b1 : -INFINITY; }
}
__device__ __forceinline__ float rowmax32(const f32x16& p0, const f32x16& p1) {
    float a = fmaxf(p0[0], p1[0]);
#pragma unroll
    for (int r = 1; r < 16; ++r) a = fmaxf(a, fmaxf(p0[r], p1[r]));
    return a;
}
__device__ __forceinline__ float max3f(float a, float b, float c) { float r; asm("v_max3_f32 %0, %1, %2, %3" : "=v"(r) : "v"(a), "v"(b), "v"(c)); return r; }
__device__ __forceinline__ void tile_step(const LAS char* Ks, const LAS char* Vs, const bf16x8* qr, f32x16* o, float& ref, float& l, LAS float* wsf,
                                          int tq, int kbase, int maxdist, bool rowok, bool near, bool allin, const LAS float* btl, float bfar, int lane) {
    const int r32 = lane & 31, hi = lane >> 5;
    f32x16 p0, p1; qkt(p0, p1, Ks, qr, r32, hi);
    if (!allin) mask_bias<true>(p0, p1, tq, kbase, 1, maxdist, rowok, btl, bfar, hi);
    if (__any(ref != 0.f)) {
#pragma unroll
        for (int r = 0; r < 16; ++r) { p0[r] -= ref; p1[r] -= ref; } }
    float a = max3f(p0[0], p0[1], p1[0]), b = max3f(p0[2], p0[3], p1[1]); a = max3f(a, p1[2], p1[3]);
#pragma unroll
    for (int r = 4; r < 16; r += 4) { a = max3f(a, p0[r], p0[r + 1]); b = max3f(b, p0[r + 2], p0[r + 3]); a = max3f(a, p1[r], p1[r + 1]); b = max3f(b, p1[r + 2], p1[r + 3]); }
    float rm = max_halves(fmaxf(a, b));
    if (allin && !rowok) rm = -INFINITY;
    if (__any(rm > 8.0f)) { const float dl = rm > 8.0f ? rm : 0.f; ref += dl; const float f = fast_exp2(-dl); l *= f;
#pragma unroll
        for (int r = 0; r < 16; ++r) { p0[r] -= dl; p1[r] -= dl; const float fr = __shfl(f, crow(r, hi)); o[0][r] *= fr; o[1][r] *= fr; } }
    float s = 0.f;
#pragma unroll
    for (int r = 0; r < 16; ++r) { p0[r] = fast_exp2(p0[r]); p1[r] = fast_exp2(p1[r]); s += p0[r] + p1[r]; }
    if (allin && !__all(rowok)) { const float okf = rowok ? 1.f : 0.f; s *= okf;
#pragma unroll
        for (int r = 0; r < 16; ++r) { p0[r] *= okf; p1[r] *= okf; } }
    l += s;
    bf16x8 pa[4]; pack_p(pa, p0, p1);
    pv(o, Vs, pa, lane, hi);
}
template <bool FIRST> __device__ __forceinline__ void add_scaled(LAS float* resl, const f32x16* o, float fac, LAS float* wsf, int lane, int r32, int hi) {
#pragma unroll
    for (int r = 0; r < 16; ++r) { const float fr = __shfl(fac, crow(r, hi));
        if (FIRST) { resl[r * 64 + lane] = o[0][r] * fr; resl[(16 + r) * 64 + lane] = o[1][r] * fr; }
        else { resl[r * 64 + lane] += o[0][r] * fr; resl[(16 + r) * 64 + lane] += o[1][r] * fr; } }
    LDS_WAIT();
}
__device__ __forceinline__ u32x4 load8(const void* p, int kind) {
    if (kind == 1) return *(const u32x4*)p;
    if (kind == 2) { const f32x4 a = ((const f32x4*)p)[0], b = ((const f32x4*)p)[1]; u32x4 w; w.x = pk2(a[0], a[1]); w.y = pk2(a[2], a[3]); w.z = pk2(b[0], b[1]); w.w = pk2(b[2], b[3]); return w; }
    return (u32x4){0u, 0u, 0u, 0u};
}

template <bool SAMPLE> __device__ __forceinline__ void attn_unit(const Params& P, const Frame& F, int b, int hkv, int qt) {
    unsigned char* ws = P.ws;
    LAS char* lds = (LAS char*)F.lds;
    const int tid = F.tid, lane = F.lane, wave = F.wave, r32 = lane & 31, hi = lane >> 5, g = wave & 3, half = wave >> 2, head = hkv * 4 + g;
    const bf16* Qb = (const bf16*)(ws + WS_Q); const bf16* KVS = (const bf16*)(ws + WS_KVS); const bf16* KVW = (const bf16*)(ws + WS_KVW);
    const float* NG = (const float*)(ws + WS_NG);
    int tok, tq, qrow; bool tvalid;
    if (SAMPLE) { tok = r32 < 3 ? r32 : 3; tvalid = (r32 < 4) && (half == 0); tq = PAST + tok; qrow = NP + b * DS + tok; }
    else { tok = 32 * half + r32; tvalid = true; tq = 64 * qt + tok; qrow = b * SEQ + tq; }
    const int ba = SAMPLE ? b : DB + b, bt = SAMPLE ? 32 : qt, tqmin = SAMPLE ? PAST : 64 * qt + 32 * half, tqmax = SAMPLE ? PAST + DS - 1 : tqmin + 31;
    bf16x8 qr[4];
#pragma unroll
    for (int d0 = 0; d0 < 4; ++d0) qr[d0] = *(const bf16x8*)(Qb + (size_t)qrow * 512 + head * 64 + hi * 8 + d0 * 16);
    float gate_c = NG[(size_t)qrow * 24 + head * 3 + 0], gate_s = NG[(size_t)qrow * 24 + head * 3 + 1], gate_w = NG[(size_t)qrow * 24 + head * 3 + 2];
    LAS float* wsf = (LAS float*)(lds + L_WS) + wave * 64;
    const LAS float* btl = (const LAS float*)(lds + L_BT) + head * 136;
    const float bfar = btl[128];
    LAS float* resl = (LAS float*)(lds + L_RES) + wave * 2048;
    const int kkey = tid >> 3, kchunk = tid & 7;
    const int vkey = kkey, vd = kchunk * 8;
    const int kdst = kchunk * 1024 + kkey * 16, vdst = ((kchunk >> 2) * 4 + (kkey >> 4)) * 1024 + (kkey & 15) * 64 + (kchunk & 3) * 16;

    __syncthreads();
    { const bf16* KCb = (const bf16*)(ws + WS_KC) + (size_t)(ba * 2 + hkv) * 128 * 64; const bf16* VCb = (const bf16*)(ws + WS_VC) + (size_t)(ba * 2 + hkv) * 128 * 64;
#pragma unroll
      for (int jt = 0; jt < 2; ++jt) { *(LAS u32x4*)(lds + L_K + jt * SLOTB + kdst) = *(const u32x4*)(KCb + (size_t)(64 * jt + kkey) * 64 + kchunk * 8);
          *(LAS u32x4*)(lds + L_V + jt * SLOTB + vdst) = *(const u32x4*)(VCb + (size_t)(64 * jt + vkey) * 64 + vd); } }
    __syncthreads();
    {
        float m = -INFINITY, l = 0.f;
#pragma unroll 1
        for (int jt = 0; jt < 2; ++jt) { f32x16 a0, a1; qkt(a0, a1, lds + L_K + jt * SLOTB, qr, r32, hi);
            mask_bias<true>(a0, a1, tq, 31 + 1024 * jt, 16, 1 << 30, tvalid, btl, bfar, hi);
            const float rm = max_halves(rowmax32(a0, a1)), mnew = fmaxf(m, rm), ms = (mnew == -INFINITY) ? 0.f : mnew; float s = 0.f;
#pragma unroll
            for (int r = 0; r < 16; ++r) s += fast_exp2(a0[r] - ms) + fast_exp2(a1[r] - ms);
            l = l * fast_exp2(m - ms) + s; m = mnew; }
        const float L = sum_halves(l), inv = L > 0.f ? 1.0f / L : 0.f, ms = (m == -INFINITY) ? 0.f : m;
        LAS float* impw = (LAS float*)(lds + L_IMP) + (g * 64 + tok) * 33;
        float eprev = 0.f;
        f32x16 o[2]; o[0] = (f32x16){}; o[1] = (f32x16){};
#pragma unroll 1
        for (int jt = 0; jt < 2; ++jt) { f32x16 a0, a1; qkt(a0, a1, lds + L_K + jt * SLOTB, qr, r32, hi);
            mask_bias<true>(a0, a1, tq, 31 + 1024 * jt, 16, 1 << 30, tvalid, btl, bfar, hi);
#pragma unroll
            for (int r = 0; r < 16; ++r) { a0[r] = fast_exp2(a0[r] - ms) * inv; a1[r] = fast_exp2(a1[r] - ms) * inv; }
#pragma unroll
            for (int n = 0; n < 8; ++n) { const int a = n & 3, c = n >> 2;
                const f32x16& pp = c ? a1 : a0;
                const float G = (pp[4 * a] + pp[4 * a + 1]) + (pp[4 * a + 2] + pp[4 * a + 3]), E = pp[4 * a + 3];
                const float eo = other_half(E, hi);
                const float imp = G + (hi ? eo : eprev);
                eprev = eo;
                if (tvalid) impw[2 * (n + 8 * jt) + hi] = imp; }
            bf16x8 pa[4]; pack_p(pa, a0, a1); pv(o, lds + L_V + jt * SLOTB, pa, lane, hi); }
        add_scaled<true>(resl, o, gate_c, wsf, lane, r32, hi);
    }
    __syncthreads();
    if (tid < 64) {
        unsigned long long mask = 0ull;
        if (!SAMPLE || tid < 4) {
            LAS float* sc = (LAS float*)(lds + L_IMP) + tid * 33;
            for (int s = 0; s < 32; ++s) sc[s] = (sc[s] + sc[64 * 33 + s]) + (sc[2 * 64 * 33 + s] + sc[3 * 64 * 33 + s]);
            mask = 1ull | (1ull << bt); if (bt >= 1) mask |= 1ull << (bt - 1);
            const int picks = 8 - __popcll(mask);
            for (int it = 0; it < picks; ++it) { int best = -1; float bv = -1.0f;
                for (int s = 1; s <= bt - 2; ++s) { const float v = sc[s]; if (!((mask >> s) & 1ull) && v > bv) { bv = v; best = s; } }
                if (best >= 0) mask |= 1ull << best; }
        }
        ((LAS unsigned*)(lds + L_SEL))[2 * tid] = (unsigned)mask; ((LAS unsigned*)(lds + L_SEL))[2 * tid + 1] = (unsigned)(mask >> 32);
        unsigned ulo = (unsigned)mask, uhi = (unsigned)(mask >> 32);
#pragma unroll
        for (int o = 1; o < 64; o <<= 1) { ulo |= __shfl_xor(ulo, o); uhi |= __shfl_xor(uhi, o); }
        if (tid == 0) { ((LAS unsigned*)(lds + L_UNI))[0] = ulo; ((LAS unsigned*)(lds + L_UNI))[1] = uhi; }
    }
    __syncthreads();
    const unsigned long long mysel = (unsigned long long)((LAS unsigned*)(lds + L_SEL))[2 * tok] | ((unsigned long long)((LAS unsigned*)(lds + L_SEL))[2 * tok + 1] << 32);
    unsigned long long U = (unsigned long long)((LAS unsigned*)(lds + L_UNI))[0] | ((unsigned long long)((LAS unsigned*)(lds + L_UNI))[1] << 32);

    const int* ptab = (const int*)P.in[I_PT] + b * 16;
#define ATT_LOAD(br, j, rk, rv) do { \
        const void* pk_ = nullptr; const void* pv_ = nullptr; int kk_ = 0, kv_ = 0; \
        if (!SAMPLE) { const bf16* src_ = (br) == 1 ? KVS : KVW; \
            pk_ = src_ + (size_t)(b * SEQ + 64 * (j) + kkey) * 256 + hkv * 64 + kchunk * 8; pv_ = src_ + (size_t)(b * SEQ + 64 * (j) + vkey) * 256 + 128 + hkv * 64 + vd; kk_ = 1; kv_ = 1; } \
        else if ((br) == 1) { const int pk0 = 64 * (j) + kkey, pv0 = 64 * (j) + vkey; \
            if (pk0 < PAST) { pk_ = P.in[I_CKS] + ((size_t)ptab[pk0 >> 7] * 128 + (pk0 & 127)) * 256 + hkv * 64 + kchunk * 8; kk_ = 2; } \
            else if (pk0 < PAST + DS) { pk_ = KVS + (size_t)(NP + b * DS + pk0 - PAST) * 256 + hkv * 64 + kchunk * 8; kk_ = 1; } \
            if (pv0 < PAST) { pv_ = P.in[I_CKS] + ((size_t)ptab[pv0 >> 7] * 128 + (pv0 & 127)) * 256 + 128 + hkv * 64 + vd; kv_ = 2; } \
            else if (pv0 < PAST + DS) { pv_ = KVS + (size_t)(NP + b * DS + pv0 - PAST) * 256 + 128 + hkv * 64 + vd; kv_ = 1; } } \
        else { const int wk0 = 64 * (j) + kkey, wv0 = 64 * (j) + vkey; \
            if (wk0 < 512) { pk_ = P.in[I_SKW] + ((size_t)b * 512 + wk0) * 256 + hkv * 64 + kchunk * 8; kk_ = 2; } \
            else if (wk0 < 512 + DS) { pk_ = KVW + (size_t)(NP + b * DS + wk0 - 512) * 256 + hkv * 64 + kchunk * 8; kk_ = 1; } \
            if (wv0 < 512) { pv_ = P.in[I_SKW] + ((size_t)b * 512 + wv0) * 256 + 128 + hkv * 64 + vd; kv_ = 2; } \
            else if (wv0 < 512 + DS) { pv_ = KVW + (size_t)(NP + b * DS + wv0 - 512) * 256 + 128 + hkv * 64 + vd; kv_ = 1; } } \
        rk = load8(pk_, kk_); rv = load8(pv_, kv_); } while (0)

    {
        f32x16 o[2]; o[0] = (f32x16){}; o[1] = (f32x16){}; float m = 0.f, l = 0.f;
        u32x4 rk, rv; int idx = 0;
        { const int j0 = __builtin_ctzll(U); ATT_LOAD(1, j0, rk, rv); }
        while (U) { const int j = __builtin_ctzll(U); U &= U - 1ull;
            const int sl = (idx & 1) * SLOTB;
            *(LAS u32x4*)(lds + L_K + sl + kdst) = rk; *(LAS u32x4*)(lds + L_V + sl + vdst) = rv;
            __syncthreads();
            if (U) { const int jn = __builtin_ctzll(U); ATT_LOAD(1, jn, rk, rv); }
            const bool rowok = tvalid && ((mysel >> j) & 1ull);
            if (__any(rowok)) { const bool near = (tqmin - (64 * j + 63)) < 128;
                tile_step(lds + L_K + sl, lds + L_V + sl, qr, o, m, l, wsf, tq, 64 * j, 1 << 30, rowok, near, !near, btl, bfar, lane); }
            ++idx; }
        const float L = sum_halves(l);
        add_scaled<false>(resl, o, L > 0.f ? gate_s / L : 0.f, wsf, lane, r32, hi);
    }
    __syncthreads();
    {
        f32x16 o[2]; o[0] = (f32x16){}; o[1] = (f32x16){}; float m = 0.f, l = 0.f;
        const int jlo = SAMPLE ? 0 : (qt >= 8 ? qt - 8 : 0), jhi = SAMPLE ? 8 : qt, kb0 = SAMPLE ? PAST - 512 : 0;
        u32x4 rk, rv; int idx = 0;
        ATT_LOAD(2, jlo, rk, rv);
        for (int j = jlo; j <= jhi; ++j) {
            const int sl = (idx & 1) * SLOTB;
            *(LAS u32x4*)(lds + L_K + sl + kdst) = rk; *(LAS u32x4*)(lds + L_V + sl + vdst) = rv;
            __syncthreads();
            if (j < jhi) { ATT_LOAD(2, j + 1, rk, rv); }
            const int kbase = kb0 + 64 * j; const bool near = (tqmin - (kbase + 63)) < 128;
            const bool allin = !near && (tqmax - kbase) <= 512;
            if (!SAMPLE || half == 0) tile_step(lds + L_K + sl, lds + L_V + sl, qr, o, m, l, wsf, tq, kbase, 512, tvalid, near, allin, btl, bfar, lane);
            ++idx; }
        const float L = sum_halves(l);
        add_scaled<false>(resl, o, L > 0.f ? gate_w / L : 0.f, wsf, lane, r32, hi);
    }
#undef ATT_LOAD
    bf16* AO = (bf16*)(ws + WS_AO);
#pragma unroll
    for (int r = 0; r < 16; ++r) { const int q = crow(r, hi);
        if (SAMPLE) { if (half == 0 && q < 4) { bf16* op = AO + (size_t)(NP + b * DS + q) * DM + head * 64 + r32; op[0] = (bf16)f2bf(resl[r * 64 + lane]); op[32] = (bf16)f2bf(resl[(16 + r) * 64 + lane]); } }
        else { bf16* op = AO + (size_t)(b * SEQ + 64 * qt + 32 * half + q) * DM + head * 64 + r32; op[0] = (bf16)f2bf(resl[r * 64 + lane]); op[32] = (bf16)f2bf(resl[(16 + r) * 64 + lane]); } }
}

__device__ __forceinline__ void attn_phase(const Params& P, const Frame& F) {
    { const float* bt = (const float*)(P.ws + WS_BIAS); LAS float* d = (LAS float*)(F.lds + L_BT); for (int e = F.tid; e < 8 * 136; e += NTHREADS) d[e] = bt[e] - bt[(e / 136) * 136 + 128]; }
    __syncthreads();
    unsigned* ctr = (unsigned*)(P.ws + WS_CTL + 2048);
    volatile LAS unsigned* slot = (volatile LAS unsigned*)(F.lds + L_UNI) + 2;
#pragma unroll 1
    for (;;) {
        if (F.tid == 0) *slot = __hip_atomic_fetch_add(ctr, 1u, __ATOMIC_RELAXED, __HIP_MEMORY_SCOPE_AGENT);
        __syncthreads();
        const unsigned u = *slot;
        __syncthreads();
        if (u >= 768u) break;
        const bool smp = u < 512u && !(u & 1u); const unsigned w = u < 512u ? (u >> 1) : u - 256u;
        if (smp) { const Frame Fu = launder(F); attn_unit<true>(P, Fu, (int)(w >> 1), (int)(w & 1u), 0); }
        else { const int qt = 31 - (int)(w >> 4), bh = (int)(w & 15u); const Frame Fu = launder(F); attn_unit<false>(P, Fu, bh >> 1, bh & 1, qt); }
    }
    __syncthreads();
}
}
namespace ssm {
constexpr int L_SLOC = 0  , L_SPREV = 32768  , L_U = 51200  , L_END = L_U + 64 * 1040;
__device__ __forceinline__ void prompt_unit(const Params& P, const Frame& F, int b, int g) {
    unsigned char* ws = P.ws; LAS char* lds = (LAS char*)F.lds;
    const int tid = F.tid, lane = F.lane, wave = F.wave, r32 = lane & 31, hi = lane >> 5;
    const bf16* U = (const bf16*)(ws + WS_U); const bf16* PT = (const bf16*)(ws + WS_PT) + (size_t)g * 128 * 512;
    const bf16* TZ = (const bf16*)(ws + WS_TZ) + (size_t)g * 512 * 512; const bf16* WC = (const bf16*)(ws + WS_WC) + (size_t)g * 512 * 128;
    LAS float* sloc = (LAS float*)(lds + L_SLOC); LAS bf16* sprev = (LAS bf16*)(lds + L_SPREV); LAS char* ul = lds + L_U;
    const int mt = wave & 1;
    __syncthreads();
    {
#pragma unroll
      for (int i = 0; i < 8; ++i) { const int p = tid + NTHREADS * i, t = p >> 1, h = p & 1;
          *(LAS u32x4*)(ul + (t >> 5) * 1040 + (t & 31) * 32 + h * 16) = *(const u32x4*)(U + (size_t)(b * SEQ + t) * 512 + g * 16 + 8 * h); } }
    __syncthreads();
    const LAS char* arow = ul + (32 * mt + r32) * 1040 + hi * 16;
    { const int nt = wave >> 1; f32x16 acc = (f32x16){}; const bf16* brow = PT + (size_t)(32 * nt + r32) * 512 + 8 * hi;
#pragma unroll 8
      for (int ks = 0; ks < 32; ++ks) { const bf16x8 a = *(const LAS bf16x8*)(arow + ks * 32), bb = *(const bf16x8*)(brow + ks * 16);
          acc = __builtin_amdgcn_mfma_f32_32x32x16_bf16(a, bb, acc, 0, 0, 0); }
#pragma unroll
      for (int r = 0; r < 16; ++r) sloc[(32 * mt + att::crow(r, hi)) * 128 + 32 * nt + r32] = acc[r]; }
    __syncthreads();
    if (tid < 64) { const int p = tid; const float* abl = (const float*)(ws + WS_ABL) + (g * 64 + p) * 2; const float ar = abl[0], ai = abl[1]; float sr = 0.f, si = 0.f;
        for (int k = 0; k < 64; ++k) { sprev[k * 136 + p] = (bf16)f2bf(sr); sprev[k * 136 + 64 + p] = (bf16)f2bf(si);
            const float lr = sloc[k * 128 + p], li = sloc[k * 128 + 64 + p]; const float nr = ar * sr - ai * si + lr, ni = ar * si + ai * sr + li; sr = nr; si = ni; }
        P.out[O_SREP + (size_t)(b * 32 + g) * 64 + p] = sr; P.out[O_SIMP + (size_t)(b * 32 + g) * 64 + p] = si; }
    __syncthreads();
    { const int nq = wave >> 1; f32x16 acc[4];
#pragma unroll
      for (int e = 0; e < 4; ++e) acc[e] = (f32x16){};
#pragma unroll 4
      for (int ks = 0; ks < 32; ++ks) { const bf16x8 a = *(const LAS bf16x8*)(arow + ks * 32);
#pragma unroll
          for (int e = 0; e < 4; ++e) { const int nt = nq * 4 + e; if (2 * nt + 1 >= ks) { const bf16x8 bb = *(const bf16x8*)(TZ + (size_t)(32 * nt + r32) * 512 + ks * 16 + 8 * hi);
              acc[e] = __builtin_amdgcn_mfma_f32_32x32x16_bf16(a, bb, acc[e], 0, 0, 0); } } }
#pragma unroll
      for (int ks = 0; ks < 8; ++ks) { const bf16x8 a = *(const LAS bf16x8*)(sprev + (32 * mt + r32) * 136 + ks * 16 + 8 * hi);
#pragma unroll
          for (int e = 0; e < 4; ++e) { const int nt = nq * 4 + e; const bf16x8 bb = *(const bf16x8*)(WC + (size_t)(32 * nt + r32) * 128 + ks * 16 + 8 * hi);
              acc[e] = __builtin_amdgcn_mfma_f32_32x32x16_bf16(a, bb, acc[e], 0, 0, 0); } }
      bf16* YG = (bf16*)(ws + WS_YG);
#pragma unroll
      for (int e = 0; e < 4; ++e) { const int n = 32 * (nq * 4 + e) + r32, j = n >> 4, c = n & 15, ch = g * 16 + c; const float dsk = P.in[I_SD][ch];
#pragma unroll
          for (int r = 0; r < 16; ++r) { const int chunk = 32 * mt + att::crow(r, hi); const size_t row = (size_t)b * SEQ + chunk * 32 + j;
              const float y = acc[e][r] + dsk * bf2f(*(const LAS bf16*)(ul + chunk * 1040 + j * 32 + c * 2)); YG[row * 512 + ch] = (bf16)f2bf(gelu_tanh(y)); } } }
}
__device__ __forceinline__ void sample_wave(const Params& P, const Frame& F, int gw, int NGW, LAS float* sw  , LAS float* cw  ) {
    unsigned char* ws = P.ws; const int lane = F.lane, p = lane, t = lane >> 4, c = lane & 15;
    const bool gconst = (NGW & 31) == 0; int gcur = -1;
    float ar = 0.f, ai = 0.f, br[16], bi[16], dsk = 0.f;
#pragma unroll
    for (int i = 0; i < 16; ++i) { br[i] = 0.f; bi[i] = 0.f; }
#pragma unroll 1
    for (int pr = gw; pr < DB * 32; pr += NGW) { const int b = pr >> 5, g = pr & 31;
        if (g != gcur) { gcur = g;
            const float* abt = (const float*)(ws + WS_ABT) + (g * 64 + p) * 2; ar = abt[0]; ai = abt[1];
            const float* bbt = (const float*)(ws + WS_BBT) + (size_t)(g * 64 + p) * 32;
#pragma unroll
            for (int c4 = 0; c4 < 8; ++c4) { const f32x4 v = *(const f32x4*)(bbt + 4 * c4); br[2 * c4] = v[0]; bi[2 * c4] = v[1]; br[2 * c4 + 1] = v[2]; bi[2 * c4 + 1] = v[3]; }
            LDS_WAIT();
#pragma unroll
            for (int cc = 0; cc < 16; ++cc) { cw[cc * 65 + p] = P.in[I_CRE][(size_t)(g * 16 + cc) * 64 + p]; cw[1040 + cc * 65 + p] = P.in[I_CIM][(size_t)(g * 16 + cc) * 64 + p]; }
            dsk = P.in[I_SD][g * 16 + c]; LDS_WAIT(); (void)gconst; }
        const bf16* U = (const bf16*)(ws + WS_U) + (size_t)(NP + b * DS) * 512 + g * 16;
        float sr = P.in[I_SRE][(size_t)(b * 32 + g) * 64 + p], si = P.in[I_SIM][(size_t)(b * 32 + g) * 64 + p];
#pragma unroll
        for (int tt = 0; tt < DS; ++tt) { const u32x4 u0 = *(const u32x4*)(U + (size_t)tt * 512), u1 = *(const u32x4*)(U + (size_t)tt * 512 + 8);
            const float uu[16] = {bflo(u0.x), bfhi(u0.x), bflo(u0.y), bfhi(u0.y), bflo(u0.z), bfhi(u0.z), bflo(u0.w), bfhi(u0.w), bflo(u1.x), bfhi(u1.x), bflo(u1.y), bfhi(u1.y), bflo(u1.z), bfhi(u1.z), bflo(u1.w), bfhi(u1.w)};
            float xr = ar * sr - ai * si, xi = ar * si + ai * sr;
#pragma unroll
            for (int cc = 0; cc < 16; ++cc) { xr += br[cc] * uu[cc]; xi += bi[cc] * uu[cc]; }
            sr = xr; si = xi; sw[(tt * 64 + p) * 2] = sr; sw[(tt * 64 + p) * 2 + 1] = si; }
        P.out[O_SRES + (size_t)(b * 32 + g) * 64 + p] = sr; P.out[O_SIMS + (size_t)(b * 32 + g) * 64 + p] = si;
        LDS_WAIT();
        float y = 0.f;
#pragma unroll 8
        for (int pp = 0; pp < 64; ++pp) y += cw[c * 65 + pp] * sw[(t * 64 + pp) * 2] - cw[1040 + c * 65 + pp] * sw[(t * 64 + pp) * 2 + 1];
        const size_t row = (size_t)NP + b * DS + t; const int ch = g * 16 + c; const float uv = bf2f(((const bf16*)(ws + WS_U))[row * 512 + ch]);
        y = gelu_tanh(y + dsk * uv); ((bf16*)(ws + WS_YG))[row * 512 + ch] = (bf16)f2bf(y);
        LDS_WAIT(); }
}
}

constexpr int SPLIT_C = 4;
__device__ __forceinline__ u32x4 gelu_pack(f32x4 x0, f32x4 x1) { u32x4 w; w.x = pk2(gelu_tanh(x0[0]), gelu_tanh(x0[1])); w.y = pk2(gelu_tanh(x0[2]), gelu_tanh(x0[3])); w.z = pk2(gelu_tanh(x1[0]), gelu_tanh(x1[1])); w.w = pk2(gelu_tanh(x1[2]), gelu_tanh(x1[3])); return w; }
constexpr int CW_STRIDE = 272, CW_CC = 2 * 64 * CW_STRIDE;
__device__ __forceinline__ void cmp_combine_item(const Params& P, LAS unsigned char* lds, int lane, int ba, int hkv, int type, int mt) {
    unsigned char* ws = P.ws; const int r32 = lane & 31, hi = lane >> 5, view = type * 2 + hkv;
    const bf16* OC = (const bf16*)(ws + WS_OUTC) + (size_t)view * NBA * 128 * 256; const LAS float* cc = (const LAS float*)(lds + CW_CC) + type * 128;
    const LAS unsigned char* W2 = lds + (type * 64 + r32) * CW_STRIDE + 16 * hi;
    const int i = 32 * mt + r32, i1 = i < 127 ? i + 1 : 127;
    f32x16 acc0 = (f32x16){}, acc1 = (f32x16){};
    if (ba >= DB) {
        const float* pv = (const float*)(ws + WS_T1) + (size_t)view * 32 * 1024 * 8; const int rl = (ba - DB) * 128 + i, rh = (ba - DB) * 128 + i1;
        constexpr size_t SLAB = (size_t)4 * 32 * 1024 * 8;
#pragma unroll 2
        for (int ks = 0; ks < 8; ++ks) { const float* plo = pv + ((size_t)(ks * 2 + hi) * 1024 + rl) * 8; const float* phh = pv + ((size_t)(16 + ks * 2 + hi) * 1024 + rh) * 8;
            f32x4 x0 = *(const LAS f32x4*)(cc + ks * 16 + 8 * hi), x1 = *(const LAS f32x4*)(cc + ks * 16 + 8 * hi + 4);
#pragma unroll
            for (int s = 0; s < SPLIT_C; ++s) { x0 = x0 + *(const f32x4*)(plo + s * SLAB) + *(const f32x4*)(phh + s * SLAB); x1 = x1 + *(const f32x4*)(plo + s * SLAB + 4) + *(const f32x4*)(phh + s * SLAB + 4); }
            const bf16x8 w = __builtin_bit_cast(bf16x8, gelu_pack(x0, x1));
            acc0 = __builtin_amdgcn_mfma_f32_32x32x16_bf16(w, *(const LAS bf16x8*)(W2 + ks * 32), acc0, 0, 0, 0);
            acc1 = __builtin_amdgcn_mfma_f32_32x32x16_bf16(w, *(const LAS bf16x8*)(W2 + 32 * CW_STRIDE + ks * 32), acc1, 0, 0, 0); }
    } else {
        const bf16* lo = OC + (size_t)(ba * 128 + i) * 256 + 8 * hi; const bf16* hh = OC + (size_t)(ba * 128 + i1) * 256 + 128 + 8 * hi;
        u32x4 av[8], cv[8];
#pragma unroll
        for (int ks = 0; ks < 8; ++ks) { av[ks] = *(const u32x4*)(lo + ks * 16); cv[ks] = *(const u32x4*)(hh + ks * 16); }
#pragma unroll
        for (int ks = 0; ks < 8; ++ks) { const u32x4 a = av[ks], c = cv[ks]; const f32x4 k0 = *(const LAS f32x4*)(cc + ks * 16 + 8 * hi), k1 = *(const LAS f32x4*)(cc + ks * 16 + 8 * hi + 4);
            const f32x4 x0 = (f32x4){bflo(a.x) + bflo(c.x), bfhi(a.x) + bfhi(c.x), bflo(a.y) + bflo(c.y), bfhi(a.y) + bfhi(c.y)} + k0, x1 = (f32x4){bflo(a.z) + bflo(c.z), bfhi(a.z) + bfhi(c.z), bflo(a.w) + bflo(c.w), bfhi(a.w) + bfhi(c.w)} + k1;
            const bf16x8 w = __builtin_bit_cast(bf16x8, gelu_pack(x0, x1));
            acc0 = __builtin_amdgcn_mfma_f32_32x32x16_bf16(w, *(const LAS bf16x8*)(W2 + ks * 32), acc0, 0, 0, 0);
            acc1 = __builtin_amdgcn_mfma_f32_32x32x16_bf16(w, *(const LAS bf16x8*)(W2 + 32 * CW_STRIDE + ks * 32), acc1, 0, 0, 0); }
    }
    bf16* O = (bf16*)(ws + (type ? WS_VC : WS_KC)) + (size_t)(ba * 2 + hkv) * 128 * 64;
#pragma unroll
    for (int r = 0; r < 16; ++r) { const int row = 32 * mt + att::crow(r, hi); O[(size_t)row * 64 + r32] = row < 127 ? (bf16)f2bf(acc0[r]) : (bf16)0; O[(size_t)row * 64 + 32 + r32] = row < 127 ? (bf16)f2bf(acc1[r]) : (bf16)0; }
}
__device__ __forceinline__ void cmp_combine_dispatch(const Params& P, LAS unsigned char* lds, int lane, int item) {
    const bool pr = item < 128; const int s = pr ? item : item - 128, u = s >> 2;
    cmp_combine_item(P, lds, lane, (pr ? DB : 0) + (u >> 2), (u >> 1) & 1, u & 1, s & 3);
}

__device__ __forceinline__ void ssm_phase(const Params& P, const Frame& F) {
    { LAS float* sw = (LAS float*)F.lds + F.wave * 512; LAS float* cw = (LAS float*)(F.lds + 16384) + F.wave * 2080;
      const bool std_grid = F.G == 256; const int c0 = (int)blockIdx.x, nb = std_grid ? 192 : F.G, ib = std_grid ? c0 - 64 : c0;
      if (ib >= 0) ssm::sample_wave(P, F, ib * NWAVES + F.wave, nb * NWAVES, sw, cw); }
    __builtin_amdgcn_sched_barrier(0);
    __syncthreads();
    const int c = (int)blockIdx.x, first = c;
#pragma unroll 1
    for (int v = first; v < 256; v += F.G) { const Frame Fu = launder(F); ssm::prompt_unit(P, Fu, v >> 5, v & 31); }
    __syncthreads();
}
__device__ __forceinline__ void misc_phase(const Params& P, const Frame& F) {
    constexpr int NIT = NBA * 4 * 4; const int gw = F.vcu * NWAVES + F.wave, NGW = F.G * NWAVES;
    if (NGW != 2048 || (int)blockIdx.x >= 132) {
        const unsigned char* wsrc = P.ws + WS_WC2;
#pragma unroll
        for (int p = 0; p < 4; ++p) { const int idx = p * NTHREADS + F.tid, row = idx >> 4, c16 = idx & 15; *(LAS u32x4*)(F.lds + row * CW_STRIDE + c16 * 16) = *(const u32x4*)(wsrc + (size_t)idx * 16); }
        if (F.tid < 64) *(LAS u32x4*)(F.lds + CW_CC + F.tid * 16) = *(const u32x4*)(P.ws + WS_CCON + F.tid * 16);
        __syncthreads(); }
    if (NGW == 2048) {
        const int b = (int)blockIdx.x, w = F.wave, hb = b - 132; int it0 = -1, it1 = -1, it2 = -1;
        if (hb >= 0) {
            if (w == 0) { it0 = hb; it1 = 128 + hb; }
            else { const int s = 124 + (hb * 7 + w - 1) * 2; it0 = 128 + s; it1 = 128 + s + 1;
                if (w <= 2) { const int e = hb * 2 + w - 1; it2 = e < 188 ? 128 + 1860 + e : (e < 192 ? 124 + e - 188 : -1); } } }
#pragma unroll 1
        for (int k = 0; k < 3; ++k) { const int it = k == 0 ? it0 : (k == 1 ? it1 : it2); if (it >= 0) { const Frame Fu = launder(F); cmp_combine_dispatch(P, Fu.lds, Fu.lane, it); } }
    } else {
#pragma unroll 1
        for (int it = gw; it < NIT; it += NGW) { const Frame Fu = launder(F); cmp_combine_dispatch(P, Fu.lds, Fu.lane, it); }
    }
}

template <int KIND, int NSPLIT> __device__ __forceinline__ void fix_phase(const Params& P, const Frame& F, const float* base, float scale, const float* ssq_in, float* ssq_out) {
    unsigned char* ws = P.ws; const float* part = (const float*)(ws + WS_T1); float* xr = (float*)(ws + WS_XR); bf16* xb = (bf16*)(ws + WS_XB); const bf16* pp = (const bf16*)(ws + WS_PP);
    const int gw = F.vcu * NWAVES + F.wave, NGW = F.G * NWAVES, lane = F.lane;
    for (int it = gw; it < NSR * 4; it += NGW) { const int sr = it >> 2, j = it & 3; const size_t row = (size_t)NP + sr; const int col = 256 * j + 4 * lane;
        f32x4 pv[NSPLIT];
#pragma unroll
        for (int ks = 0; ks < NSPLIT; ++ks) pv[ks] = *(const f32x4*)(part + ((size_t)ks * NSR + sr) * DM + col);
        f32x4 a = pv[0];
#pragma unroll
        for (int ks = 1; ks < NSPLIT; ++ks) a = a + pv[ks];
        f32x4 x;
        if (KIND == 0) x = *(const f32x4*)(base + (size_t)sr * DM + col) + a * scale;
        else { const float rs = rstd_of(ssq_in[row]); const u32x2 w = *(const u32x2*)(pp + row * DM + col); x = *(const f32x4*)(xr + row * DM + col);
            x[0] += sigmoidf_(a[0] * rs) * bflo(w.x); x[1] += sigmoidf_(a[1] * rs) * bfhi(w.x); x[2] += sigmoidf_(a[2] * rs) * bflo(w.y); x[3] += sigmoidf_(a[3] * rs) * bfhi(w.y); }
        *(f32x4*)(xr + row * DM + col) = x; u32x2 o; o.x = pk2(x[0], x[1]); o.y = pk2(x[2], x[3]); *(u32x2*)(xb + row * DM + col) = o;
        const float ss = wave_sum((x[0] * x[0] + x[1] * x[1]) + (x[2] * x[2] + x[3] * x[3])); if (lane == 0) atomicAdd(ssq_out + row, ss); }
}

__device__ __forceinline__ void final_phase(const Params& P, const Frame& F) {
    const float* xr = (const float*)(P.ws + WS_XR); const float* ssq = (const float*)(P.ws + WS_SSQ) + 3 * MR; const float* gf = P.in[I_GFIN];
    const int gw = F.vcu * NWAVES + F.wave, NGW = F.G * NWAVES, lane = F.lane;
    f32x4 gv[4];
#pragma unroll
    for (int j = 0; j < 4; ++j) gv[j] = *(const f32x4*)(gf + 256 * j + 4 * lane);
    const bf16* xq = (const bf16*)(P.ws + WS_TT);
    for (int m = gw; m < MR; m += NGW) { const float rs = rstd_of(ssq[m]);
        if (m < NP) {
#pragma unroll
            for (int j = 0; j < 4; ++j) { const u32x2 w = *(const u32x2*)(xq + (size_t)m * DM + 256 * j + 4 * lane); const f32x4 v = (f32x4){bflo(w.x), bfhi(w.x), bflo(w.y), bfhi(w.y)}; *(f32x4*)(P.out + (size_t)m * DM + 256 * j + 4 * lane) = v * rs * gv[j]; } }
        else {
#pragma unroll
            for (int j = 0; j < 4; ++j) { const f32x4 v = *(const f32x4*)(xr + (size_t)m * DM + 256 * j + 4 * lane); *(f32x4*)(P.out + (size_t)m * DM + 256 * j + 4 * lane) = v * rs * gv[j]; } } }
}
#define XB_TMO      128
#define XB_XCNT(j)  (256  + 64 * (j))
#define XB_XSUB(j)  (1280 + 64 * (j))
#define XB_XGEN(j)  (2304 + 64 * (j))
#define XB_TOP      3328
#define XB_TOPGEN   3392
#define XCD_BAR_WORDS 3456
#define XB_SPIN_CAP (1u << 18)

__device__ __forceinline__ unsigned xb_ld(unsigned* p)              { return __hip_atomic_load(p, __ATOMIC_RELAXED, __HIP_MEMORY_SCOPE_AGENT); }
__device__ __forceinline__ unsigned xb_add(unsigned* p, unsigned v) { return __hip_atomic_fetch_add(p, v, __ATOMIC_RELAXED, __HIP_MEMORY_SCOPE_AGENT); }
__device__ __forceinline__ unsigned xb_xcc_id() { return (unsigned)__builtin_amdgcn_s_getreg((3 << 11) | 20) & 0xFu; }
#define XB_SPIN(cond, bar) do { unsigned _sp = 0; while (cond) { __builtin_amdgcn_s_sleep(1); \
    if ((++_sp & 255u) == 0u) { if (xb_ld(&(bar)[XB_TMO])) break; if (_sp > XB_SPIN_CAP) { atomicAdd(&(bar)[XB_TMO], 1u); break; } } } } while (0)

struct XcdBarrier {
    unsigned* bar; unsigned x;
    volatile LAS unsigned* st;
};

__device__ __forceinline__ XcdBarrier xcd_barrier_post(unsigned* bar, volatile LAS unsigned* st) {
    XcdBarrier b; b.bar = bar; b.x = xb_xcc_id(); b.st = st;
    if (threadIdx.x == 0) (void)xb_add(&bar[XB_XCNT(b.x)], 1u);
    return b;
}
__device__ __forceinline__ void xcd_barrier_complete(unsigned* bar, unsigned x, unsigned& nloc, unsigned& nx) {
    const unsigned G = gridDim.x * gridDim.y * gridDim.z;
    unsigned sum, cnt, mine, sp = 0u;
    for (;;) {
        sum = 0u; cnt = 0u; mine = 0u;
#pragma unroll
        for (unsigned j = 0; j < 16; ++j) { const unsigned c = xb_ld(&bar[XB_XCNT(j)]); sum += c; cnt += (c > 0u) ? 1u : 0u; mine = (j == x) ? c : mine; }
        if (sum == G) break;
        __builtin_amdgcn_s_sleep(1);
        if ((++sp & 255u) == 0u) { if (xb_ld(&bar[XB_TMO])) break; if (sp > XB_SPIN_CAP) { atomicAdd(&bar[XB_TMO], 1u); break; } }
    }
    nloc = mine > 0u ? mine : 1u; nx = cnt > 0u ? cnt : 1u;
}

__device__ __forceinline__ void xcd_barrier(const XcdBarrier& b) {
    asm volatile("s_waitcnt vmcnt(0)" ::: "memory");
    __syncthreads();
    if (threadIdx.x == 0) {
        unsigned* bar = b.bar;
        __builtin_amdgcn_s_waitcnt(0);
        unsigned nloc = b.st[0], nx = b.st[1];
        if (nloc == 0u) { xcd_barrier_complete(bar, b.x, nloc, nx); b.st[0] = nloc; b.st[1] = nx; }
        const unsigned old = xb_add(&bar[XB_XSUB(b.x)], 1u);
        const unsigned gen = old / nloc;
        if (old + 1u == (gen + 1u) * nloc) {
            __builtin_amdgcn_fence(__ATOMIC_RELEASE, "agent");
            asm volatile("s_waitcnt vmcnt(0)" ::: "memory");
            const unsigned og = xb_add(&bar[XB_TOP], 1u);
            const unsigned tg = og / nx;
            if (og + 1u == (tg + 1u) * nx) xb_add(&bar[XB_TOPGEN], 1u);
            else XB_SPIN(xb_ld(&bar[XB_TOPGEN]) == tg, bar);
            __builtin_amdgcn_fence(__ATOMIC_ACQUIRE, "agent");
            xb_add(&bar[XB_XGEN(b.x)], 1u);
            asm volatile("s_waitcnt vmcnt(0)" ::: "memory");
        } else {
            XB_SPIN(xb_ld(&bar[XB_XGEN(b.x)]) == gen, bar);
            __builtin_amdgcn_fence(__ATOMIC_ACQUIRE, "agent");
            asm volatile("s_waitcnt vmcnt(0)" ::: "memory");
        }
    }
    __syncthreads();
}


constexpr int LDS_BYTES = 147456;
enum Phase { PH_PRO = 0, PH_GU1, PH_D1, PH_FIX1, PH_WIN, PH_CMPG, PH_SSM, PH_MISC, PH_GLU, PH_ATT, PH_MG1, PH_MG2, PH_WOUT, PH_FIX2, PH_GU2, PH_D2, PH_FIX3, PH_PPROJ, PH_PGATE, PH_FIX4, PH_FINAL, PH_N };
constexpr int SPLIT_D = 11, SPLIT_O = 4;

#ifndef PH_MASK
#define PH_MASK 0x1FFFFF
#endif
#define EN(k) (((PH_MASK) >> (k)) & 1)
template <int PH> __device__ __forceinline__ void run_phase(const Params& P, const Frame& F, unsigned char* ws) {
    using namespace pg8;
    float* ssq1 = (float*)(ws + WS_SSQ); float* ssq2 = ssq1 + MR; float* ssq3 = ssq2 + MR; float* ssq4 = ssq3 + MR; const float* ssq0 = (const float*)(ws + WS_SSQ0);
    bf16* XB = (bf16*)(ws + WS_XB); float* XR = (float*)(ws + WS_XR); bf16* H = (bf16*)(ws + WS_H);
    Gemm g{}; g.vt = 0; g.vstride = 0; g.bdiv = 0; g.kstepA = BK; g.M = MR;
    StaticOrder S;
    if constexpr (!EN(PH)) { return; }
    else if constexpr (PH == PH_PRO) prologue(P, F);
    else if constexpr (PH == PH_GU1 || PH == PH_GU2) { constexpr bool two = PH == PH_GU2;
        g.A = XB; g.Bt = (const bf16*)(ws + (two ? WS_WGU2 : WS_WGU1)); g.N = 2 * FF; g.K = DM; g.lda = DM; S.init(MR, 2 * FF, F.G, (int)blockIdx.x, DM);
        EpiSwiglu E{H, FF, two ? ssq2 : ssq0};
        gemm_phase<EpiSwiglu, StaticOrder, true, true>(F.lds, g, S, E); }
    else if constexpr (PH == PH_D1 || PH == PH_D2 || PH == PH_WOUT) {
        EpiResid E;
        if constexpr (PH == PH_D1) { g.A = H; g.Bt = (const bf16*)(ws + WS_WD1); g.K = FF; g.lda = FF; E = EpiResid{P.in[I_XP], P.in[I_XS], XR, XB, ssq1, 0.5f, nullptr, 2}; }
        else if constexpr (PH == PH_D2) { g.A = H; g.Bt = (const bf16*)(ws + WS_WD2); g.K = FF; g.lda = FF; E = EpiResid{XR, XR + (size_t)NP * DM, XR, XB, ssq3, 0.5f, (float*)(ws + WS_T1), 3}; }
        else { g.A = (const bf16*)(ws + WS_TT); g.Bt = (const bf16*)(ws + WS_WOUT); g.K = DM; g.lda = DM; E = EpiResid{XR, XR + (size_t)NP * DM, XR, XB, ssq2, 1.0f, (float*)(ws + WS_T1), 3}; }
        g.N = DM;
        if constexpr (PH == PH_D1) { S.init(MR, DM, F.G, (int)blockIdx.x, g.K); gemm_phase<EpiResid, StaticOrder, true, true>(F.lds, g, S, E);
            if (F.G == 256) { if ((int)blockIdx.x >= 8) { const int ib = (int)blockIdx.x - 8; for (int it = ib; it < 256; it += 248) ssm_tables_item(P, (LAS float*)F.lds, it, F.tid);
                    background_copy<1 | 8>(P, ib * NWAVES + F.wave, 248 * NWAVES, F.lane, (LAS float*)(F.lds + F.wave * 16384)); } }
            else { for (int it = blockIdx.x; it < 256; it += F.G) ssm_tables_item(P, (LAS float*)F.lds, it, F.tid);
                background_copy<63>(P, (int)blockIdx.x * NWAVES + F.wave, F.G * NWAVES, F.lane, (LAS float*)(F.lds + F.wave * 16384)); }
        } else { S.init(MR, DM, F.G, (int)blockIdx.x, g.K, NP, PH == PH_WOUT ? SPLIT_O : SPLIT_D); gemm_phase<EpiResid, StaticOrder, true, true>(F.lds, g, S, E); } }
    else if constexpr (PH == PH_WIN) { g.A = XB; g.Bt = (const bf16*)(ws + WS_WIN); g.N = NIN; g.K = DM; g.lda = DM; S.init(MR, NIN, F.G, (int)blockIdx.x, DM);
        EpiWin E{ssq1, P.out, (bf16*)(ws + WS_Q), (bf16*)(ws + WS_CCB) + (size_t)DB * 2048 * 256, (bf16*)(ws + WS_KVS), (bf16*)(ws + WS_KVW), (bf16*)(ws + WS_U), (bf16*)(ws + WS_MG), (float*)(ws + WS_NG)};
        gemm_phase<EpiWin, StaticOrder, true, true>(F.lds, g, S, E);
        if (F.G == 256 && (int)blockIdx.x >= 32) background_copy<2 | 4>(P, ((int)blockIdx.x - 32) * NWAVES + F.wave, 224 * NWAVES, F.lane, (LAS float*)(F.lds + F.wave * 16384)); }
    else if constexpr (PH == PH_CMPG) { g.A = (const bf16*)(ws + WS_CCB); g.Bt = (const bf16*)(ws + WS_WC1); g.M = 4 * NBA * 128; g.N = 256; g.K = 1024; g.lda = 4096; g.kstepA = 256; g.vt = NBA * 128 / 256; g.vstride = 64; g.bdiv = 2 * (NBA * 128 / 256);
        EpiPlain E{(bf16*)(ws + WS_OUTC), 256, (float*)(ws + WS_T1), NBA * 128 / 256, DB * 128 / 256}; S.init_views(4, NBA * 128 / 256, DB * 128 / 256, SPLIT_C, 1024, F.G, (int)blockIdx.x);
        gemm_phase<EpiPlain, StaticOrder, true, true>(F.lds, g, S, E); }
    else if constexpr (PH == PH_PPROJ) { g.A = (const bf16*)(ws + WS_PB); g.Bt = (const bf16*)(ws + WS_WPP); g.N = DM; g.K = PLE; g.lda = PLE; EpiPlain E{(bf16*)(ws + WS_PP), DM, nullptr, 1, 1}; S.init(MR, DM, F.G, (int)blockIdx.x, PLE, NP, 1);
        gemm_phase<EpiPlain, StaticOrder, true, true>(F.lds, g, S, E); }
    else if constexpr (PH == PH_SSM) ssm_phase(P, F);
    else if constexpr (PH == PH_MISC) misc_phase(P, F);
    else if constexpr (PH == PH_ATT) att::attn_phase(P, F);
    else if constexpr (PH == PH_GLU) { g.A = (const bf16*)(ws + WS_YG); g.Bt = (const bf16*)(ws + WS_WGLU); g.N = 512; g.K = 512; g.lda = 512; S.init(MR, 512, F.G, (int)blockIdx.x, 512);
        EpiGlu E{(const bf16*)(ws + WS_YG), (bf16*)(ws + WS_AO)};
        gemm_phase<EpiGlu, StaticOrder, true, true>(F.lds, g, S, E);
    }
    else if constexpr (PH == PH_MG1) { g.A = (const bf16*)(ws + WS_AO); g.Bt = (const bf16*)(ws + WS_WBA); g.N = DM; g.K = DM; g.lda = DM; S.init(MR, DM, F.G, (int)blockIdx.x, DM);
        EpiMerge E{(const bf16*)(ws + WS_MG), (bf16*)(ws + WS_TT)};
        gemm_phase<EpiMerge, StaticOrder, true, true>(F.lds, g, S, E);
        if (F.G == 256 && (int)blockIdx.x >= 8) background_copy<16 | 32>(P, ((int)blockIdx.x - 8) * NWAVES + F.wave, 248 * NWAVES, F.lane, (LAS float*)(F.lds + F.wave * 16384)); }
    else if constexpr (PH == PH_PGATE) { g.A = XB; g.Bt = (const bf16*)(ws + WS_WPG); g.N = DM; g.K = DM; g.lda = DM; S.init(MR, DM, F.G, (int)blockIdx.x, DM, NP, SPLIT_O);
        EpiPleGate E{ssq3, (const bf16*)(ws + WS_PP), XR, ssq4, (float*)(ws + WS_T1), XB, (bf16*)(ws + WS_TT)};
        gemm_phase<EpiPleGate, StaticOrder, true, true>(F.lds, g, S, E); }
    else if constexpr (PH == PH_FIX2) fix_phase<0, SPLIT_O>(P, F, XR + (size_t)NP * DM, 1.0f, nullptr, ssq2);
    else if constexpr (PH == PH_FIX3) fix_phase<0, SPLIT_D>(P, F, XR + (size_t)NP * DM, 0.5f, nullptr, ssq3);
    else if constexpr (PH == PH_FIX4) fix_phase<1, SPLIT_O>(P, F, nullptr, 0.f, ssq3, ssq4);
    else if constexpr (PH == PH_FINAL) final_phase(P, F);
}

__global__ void __launch_bounds__(NTHREADS, 2) mega_fwd(Params P) {
    extern __shared__ __attribute__((aligned(16))) unsigned char lds_raw[];
    Frame F0; F0.lds = (LAS unsigned char*)lds_raw; F0.tid = threadIdx.x; F0.lane = F0.tid & 63; F0.wave = __builtin_amdgcn_readfirstlane(F0.tid >> 6);
    F0.G = gridDim.x; { const int bx = blockIdx.x; F0.vcu = (F0.G % 8 == 0) ? (bx % 8) * (F0.G / 8) + bx / 8 : bx; }
    const int lo = P.ph_lo, hi = P.ph_hi;
    volatile LAS unsigned* bst = (volatile LAS unsigned*)(F0.lds + LDS_BYTES - 64);
    if (F0.tid < 2) bst[F0.tid] = 0u;
    __syncthreads();
    XcdBarrier bar; bar.bar = (unsigned*)(P.ws + WS_CTL) + 1024; bar.x = 0; bar.st = bst;
    if (P.coop) bar = xcd_barrier_post((unsigned*)(P.ws + WS_CTL) + 1024, bst);
#ifdef TPROBE
#ifndef TP_A0
#define TP_A0 0
#define TP_A1 256
#define TP_B0 0
#define TP_B1 256
#endif
#define TSTAMP(k) if (threadIdx.x == 0) { ((unsigned long long*)(P.ws + WS_CTL + (1u << 20)))[(k) * 256 + blockIdx.x] = __builtin_amdgcn_s_memrealtime(); }
    TSTAMP(21)
#else
#define TSTAMP(k)
#endif
#define RUN(k) if ((k) != PH_FIX1 && (k) != PH_MG2 && lo <= (k) && (k) < hi) { Frame F = launder(F0); unsigned char* ws = P.ws; asm volatile("" : "+s"(ws)); run_phase<k>(P, F, ws); TSTAMP(k) if ((k) == PH_CMPG || (k) == PH_MISC || (k) == PH_FIX3 || (k) == PH_PPROJ) { __builtin_amdgcn_sched_barrier(0); __syncthreads(); asm volatile("" ::: "memory"); } else if ((k) + 1 < hi && P.coop) { if (P.coop == 2) cg::this_grid().sync(); else xcd_barrier(bar); } }
    RUN(0) RUN(1) RUN(2) RUN(3) RUN(4) RUN(5) RUN(6) RUN(7) RUN(8) RUN(9) RUN(10) RUN(11) RUN(12) RUN(13) RUN(14) RUN(15) RUN(16) RUN(17) RUN(18) RUN(19) RUN(20)
#undef RUN
#ifdef TPROBE
    xcd_barrier(bar);
    if (blockIdx.x == 0 && threadIdx.x == 0) { const volatile unsigned long long* ts = (const volatile unsigned long long*)(P.ws + WS_CTL + (1u << 20));
        unsigned long long qa, qb;
        { unsigned long long mk = 0, mp = 0, np = ~0ull;
#pragma unroll 1
            for (int b = 0; b < 256; ++b) { const unsigned long long a = (b >= TP_A0 && b < TP_A1) ? ts[TP_KA * 256 + b] : 0ull, c = ts[TP_PA * 256 + b]; mk = a > mk ? a : mk; mp = c > mp ? c : mp; np = c < np ? c : np; }
            qa = mk - ((TP_PA == TP_KA || TP_PA == 21) ? np : mp); }
        { unsigned long long mk = 0, mp = 0, np = ~0ull;
#pragma unroll 1
            for (int b = 0; b < 256; ++b) { const unsigned long long a = (b >= TP_B0 && b < TP_B1) ? ts[TP_KB * 256 + b] : 0ull, c = ts[TP_PB * 256 + b]; mk = a > mk ? a : mk; mp = c > mp ? c : mp; np = c < np ? c : np; }
            qb = mk - ((TP_PB == TP_KB || TP_PB == 21) ? np : mp); }
        const unsigned long long ticks = qa * 10 + (qb / 200) * 250000ull, t0 = __builtin_amdgcn_s_memrealtime();
        while (__builtin_amdgcn_s_memrealtime() - t0 < ticks) __builtin_amdgcn_s_sleep(20);
    }
#endif
}

extern "C" void kernel_launch(void* const* d_in, const int* in_sizes, int n_in, void* d_out, int out_size, void* d_ws, size_t ws_size, hipStream_t stream) {
    static int grid = 0;
    if (grid == 0) {
        if (n_in != 45 || (size_t)out_size != O_END || ws_size < WS_END) { fprintf(stderr, "kernel_launch: unexpected shapes: n_in %d out %d ws %zu (need %zu)\n", n_in, out_size, ws_size, (size_t)WS_END); grid = -1; return; }
        int dev = 0, cus = 0, per_cu = 0;
        (void)hipGetDevice(&dev); (void)hipDeviceGetAttribute(&cus, hipDeviceAttributeMultiprocessorCount, dev);
        if (hipFuncSetAttribute((const void*)mega_fwd, hipFuncAttributeMaxDynamicSharedMemorySize, LDS_BYTES) != hipSuccess) { fprintf(stderr, "kernel_launch: hipFuncSetAttribute failed\n"); grid = -1; return; }
        if (hipOccupancyMaxActiveBlocksPerMultiprocessor(&per_cu, (const void*)mega_fwd, NTHREADS, LDS_BYTES) != hipSuccess || per_cu < 1) { fprintf(stderr, "kernel_launch: occupancy query says %d blocks per CU\n", per_cu); per_cu = 1; }
        (void)hipGetLastError();
        grid = cus;
        if (grid <= 0) grid = 256;
    }
    if (grid < 0) return;
    (void)hipMemsetAsync((char*)d_ws + WS_CTL, 0, CTL_BYTES, stream);
    Params p{};
    for (int i = 0; i < 45; ++i) p.in[i] = (const float*)d_in[i];
    p.out = (float*)d_out; p.ws = (unsigned char*)d_ws;
    for (int n = 0; n < 128; ++n) { int bk; if (n < 16) bk = n; else { bk = 16 + (int)(std::log((double)n / 16.0) / std::log(8.0) * 16.0); if (bk > 31) bk = 31; } p.bucket[n] = (unsigned char)bk; }
#if MK_ONE_LAUNCH
    p.ph_lo = 0; p.ph_hi = PH_N; p.coop = 1;
    void* args[] = {&p};
    hipError_t e = hipLaunchCooperativeKernel((const void*)mega_fwd, dim3(grid), dim3(NTHREADS), args, LDS_BYTES, stream);
    if (e != hipSuccess) fprintf(stderr, "kernel_launch: cooperative launch failed: %s (grid %d)\n", hipGetErrorString(e), grid);
#else
    for (int ph = 0; ph < PH_N; ++ph) { p.ph_lo = ph; p.ph_hi = ph + 1; p.coop = 0; hipLaunchKernelGGL(mega_fwd, dim3(grid), dim3(NTHREADS), LDS_BYTES, stream, p); }
#endif
}
```
